# Optimizing an MI355X kernel written in HIP

```python
import jax, jax.numpy as jnp
from jax import lax
import numpy as np

D_MODEL = 2048
BATCH = 4
SEQ = 4096
DEPTH = 1

HEAD_DIM = 128
H_A = 8
KV_A = 2
G_A = H_A // KV_A
H_B = 8
KV_B = 2
G_B = H_B // KV_B
MIX_WIDTH = (H_A + H_B) * HEAD_DIM
WINDOW = 128
BLOCK = 128
GRID_W = 64
ROPE_THETA = 10000.0
N_EXPERTS = 16
CAPACITY_FACTOR = 2
D_FF = 2 * D_MODEL
EPS = 1e-6
NEG_INF = -1e30
SCALE = HEAD_DIM ** -0.5
COLS = [H_A * HEAD_DIM, KV_A * HEAD_DIM, KV_A * HEAD_DIM,
        H_B * HEAD_DIM, KV_B * HEAD_DIM, KV_B * HEAD_DIM]
D_IN = sum(COLS)
SPLITS = [int(v) for v in np.cumsum(COLS)[:-1]]

kernel_name = "hymba_window_sink_axialrope_ec_moe"


def rms_norm(x, g):
    xf = x.astype(jnp.float32)
    y = xf * lax.rsqrt(jnp.mean(xf * xf, axis=-1, keepdims=True) + EPS)
    return (y * g.astype(jnp.float32)).astype(x.dtype)


def alibi_slopes(n):
    return jnp.asarray(2.0 ** (-8.0 * np.arange(1, n + 1) / n), dtype=jnp.float32)


def windowed_sink_attention(q, k, v, sink):
    B, S = q.shape[0], q.shape[1]
    nb = S // BLOCK
    qb = q.reshape(B, nb, BLOCK, KV_A, G_A, HEAD_DIM)

    def band(t):
        tp = jnp.pad(t, ((0, 0), (BLOCK, BLOCK), (0, 0), (0, 0)))
        tp = tp.reshape(B, nb + 2, BLOCK, KV_A, HEAD_DIM)
        return jnp.concatenate([tp[:, :-2], tp[:, 1:-1], tp[:, 2:]], axis=2)

    kw, vw = band(k), band(v)
    s = jnp.einsum('bnqkgd,bnjkd->bnkgqj', qb, kw,
                   preferred_element_type=jnp.float32) * SCALE
    qi = jnp.arange(BLOCK)
    kj = jnp.arange(3 * BLOCK)
    dist = qi[:, None] + BLOCK - kj[None, :]
    kpos = jnp.arange(nb)[:, None] * BLOCK - BLOCK + kj[None, :]
    valid = (jnp.abs(dist) <= WINDOW)[None] & ((kpos >= 0) & (kpos < S))[:, None, :]
    slopes = alibi_slopes(H_A).reshape(KV_A, G_A)
    bias = -slopes[:, :, None, None] * jnp.abs(dist).astype(jnp.float32)[None, None]
    s = jnp.where(valid[None, :, None, None], s + bias[None, None], NEG_INF)
    sinkc = jnp.broadcast_to(sink.astype(jnp.float32).reshape(KV_A, G_A, 1, 1),
                             s.shape[:-1] + (1,))
    p = jax.nn.softmax(jnp.concatenate([s, sinkc], axis=-1), axis=-1)[..., :-1]
    o = jnp.einsum('bnkgqj,bnjkd->bnqkgd', p.astype(v.dtype), vw)
    return o.reshape(B, S, H_A * HEAD_DIM)


def axial_rope(t, row, col):
    half = HEAD_DIM // 2
    inv_freq = ROPE_THETA ** (-jnp.arange(0, half, 2, dtype=jnp.float32) / half)

    def rotate(seg, pos):
        ang = pos.astype(jnp.float32)[:, None] * inv_freq[None, :]
        cos = jnp.cos(ang)[None, :, None, :]
        sin = jnp.sin(ang)[None, :, None, :]
        s1, s2 = jnp.split(seg.astype(jnp.float32), 2, axis=-1)
        return jnp.concatenate([s1 * cos - s2 * sin, s2 * cos + s1 * sin], axis=-1)

    out = jnp.concatenate([rotate(t[..., :half], row), rotate(t[..., half:], col)], axis=-1)
    return out.astype(t.dtype)


def grid_attention(q, k, v):
    B, S = q.shape[0], q.shape[1]
    nb = S // BLOCK
    qb = jnp.moveaxis(q.reshape(B, nb, BLOCK, KV_B, G_B, HEAD_DIM), 1, 0)

    def one_block(qblk):
        s = jnp.einsum('bqkgd,bskd->bkgqs', qblk, k,
                       preferred_element_type=jnp.float32) * SCALE
        p = jax.nn.softmax(s, axis=-1)
        return jnp.einsum('bkgqs,bskd->bqkgd', p.astype(v.dtype), v)

    o = lax.map(one_block, qb)
    return jnp.moveaxis(o, 0, 1).reshape(B, S, H_B * HEAD_DIM)


def expert_choice_ffn(h, w_router, w_gate, w_up, w_down):
    B, S, _ = h.shape
    cap = CAPACITY_FACTOR * S // N_EXPERTS
    logits = jnp.einsum('bsd,de->bse', h, w_router, preferred_element_type=jnp.float32)
    aff = jax.nn.softmax(logits, axis=-1)
    gates, idx = lax.top_k(jnp.swapaxes(aff, 1, 2), cap)
    b_idx = jnp.arange(B)[:, None, None]
    xg = h[b_idx, idx]
    a = jnp.einsum('becd,edf->becf', xg, w_gate)
    u = jnp.einsum('becd,edf->becf', xg, w_up)
    eo = jnp.einsum('becf,efd->becd', jax.nn.silu(a) * u, w_down)
    eo = eo * gates[..., None].astype(eo.dtype)
    return jnp.zeros_like(h).at[b_idx, idx].add(eo)


def hybrid_layer(x, row, col, norm_mix, w_in, sink_a, q_norm_b, k_norm_b, w_out,
                 norm_ffn, w_router, w_gate, w_up, w_down):
    B, S, _ = x.shape
    h = rms_norm(x, norm_mix)
    proj = jnp.einsum('bsd,de->bse', h, w_in)
    qa, ka, va, qb, kb, vb = jnp.split(proj, SPLITS, axis=-1)
    qa = qa.reshape(B, S, H_A, HEAD_DIM)
    ka = ka.reshape(B, S, KV_A, HEAD_DIM)
    va = va.reshape(B, S, KV_A, HEAD_DIM)
    qb = axial_rope(rms_norm(qb.reshape(B, S, H_B, HEAD_DIM), q_norm_b), row, col)
    kb = axial_rope(rms_norm(kb.reshape(B, S, KV_B, HEAD_DIM), k_norm_b), row, col)
    vb = vb.reshape(B, S, KV_B, HEAD_DIM)
    oa = windowed_sink_attention(qa, ka, va, sink_a)
    ob = grid_attention(qb, kb, vb)
    mix = jnp.einsum('bse,ed->bsd', jnp.concatenate([oa, ob], axis=-1), w_out)
    x = x + mix
    x = x + expert_choice_ffn(rms_norm(x, norm_ffn), w_router, w_gate, w_up, w_down)
    return x


def setup_inputs(seed: int = 0) -> dict:
    key = jax.random.key(seed)
    ks = jax.random.split(key, 13)
    f32 = jnp.float32
    L = DEPTH
    return {
        'x': jax.random.normal(ks[0], (BATCH, SEQ, D_MODEL), f32),
        'norm_mix': 1.0 + 0.02 * jax.random.normal(ks[1], (L, D_MODEL), f32),
        'w_in': jax.random.normal(ks[2], (L, D_MODEL, D_IN), f32) * D_MODEL ** -0.5,
        'sink_a': 0.5 * jax.random.normal(ks[3], (L, H_A), f32),
        'q_norm_b': 1.0 + 0.02 * jax.random.normal(ks[4], (L, HEAD_DIM), f32),
        'k_norm_b': 1.0 + 0.02 * jax.random.normal(ks[5], (L, HEAD_DIM), f32),
        'w_out': jax.random.normal(ks[6], (L, MIX_WIDTH, D_MODEL), f32) * MIX_WIDTH ** -0.5,
        'norm_ffn': 1.0 + 0.02 * jax.random.normal(ks[7], (L, D_MODEL), f32),
        'w_router': jax.random.normal(ks[8], (L, D_MODEL, N_EXPERTS), f32) * D_MODEL ** -0.5,
        'w_gate': jax.random.normal(ks[9], (L, N_EXPERTS, D_MODEL, D_FF), f32) * D_MODEL ** -0.5,
        'w_up': jax.random.normal(ks[10], (L, N_EXPERTS, D_MODEL, D_FF), f32) * D_MODEL ** -0.5,
        'w_down': jax.random.normal(ks[11], (L, N_EXPERTS, D_FF, D_MODEL), f32) * D_FF ** -0.5,
        'norm_final': 1.0 + 0.02 * jax.random.normal(ks[12], (D_MODEL,), f32),
    }


def reference(x, norm_mix, w_in, sink_a, q_norm_b, k_norm_b, w_out, norm_ffn,
              w_router, w_gate, w_up, w_down, norm_final):
    S = x.shape[1]
    rows = S // GRID_W
    row = jnp.broadcast_to(jnp.arange(rows)[:, None], (rows, GRID_W)).reshape(S)
    col = jnp.broadcast_to(jnp.arange(GRID_W)[None, :], (rows, GRID_W)).reshape(S)
    for l in range(DEPTH):
        x = hybrid_layer(x, row, col, norm_mix[l], w_in[l], sink_a[l], q_norm_b[l],
                         k_norm_b[l], w_out[l], norm_ffn[l], w_router[l], w_gate[l],
                         w_up[l], w_down[l])
    return rms_norm(x, norm_final)
```

```cpp
#include <hip/hip_runtime.h>
#include <cstdio>
#include <cstdint>

#ifndef ATT_SD_B
#define ATT_SD_B 2
#endif
#ifndef ATT_SD_A
#define ATT_SD_A 1
#endif
#ifndef DUP_MASK
#define DUP_MASK 0
#endif
#define REP(k) for (int _r = 0; _r < (((DUP_MASK >> (k)) & 1) ? 2 : 1); ++_r)
#ifndef MK_SPLIT
#define MK_SPLIT 0
#endif

constexpr int BATCH = 4, SEQ = 4096, DM = 2048, T = BATCH * SEQ, DIN = 3072, HD = 128;
constexpr int NE = 16, CAP = 512, DFF = 4096, MS = BATCH * NE * CAP;
constexpr float EPS = 1e-6f;
constexpr int COL_QA = 0, COL_KA = 1024, COL_VA = 1280, COL_QB = 1536, COL_KB = 2560, COL_VB = 2816;
constexpr int NPHASE = 11;
constexpr float QSQ = 0.088388347648318440f * 1.4426950408889634f * 2048.f / 16.f;
constexpr float QS = 16.f, PSC = 8.f;
constexpr float HS = 16.f, WIS = 1024.f, OS = 32.f;
constexpr float XS = 16.f, WS = 1024.f, AS = 16.f, WDS = 2048.f;
static_assert(COL_VA - COL_KA == 256 && COL_VB - COL_KB == 256, "V sits 256 columns right of K");

constexpr size_t MiB = 1u << 20;
constexpr size_t WS_CTL = 0, CTL_ZERO_BYTES = 1 * MiB;
constexpr size_t WS_AFF = 1 * MiB;
constexpr size_t WS_IDX = 2 * MiB;
constexpr size_t WS_GATE = 3 * MiB;
constexpr size_t WS_SLOT = 4 * MiB;
constexpr size_t WS_RSTD = 5 * MiB;
constexpr size_t WS_RS = 6 * MiB;
constexpr size_t WS_ROPE = 7 * MiB;
constexpr size_t WS_WIN = 8 * MiB;
constexpr size_t WS_WOUT = 20 * MiB;
constexpr size_t WS_HN = 32 * MiB;
constexpr size_t WS_PROJ = 96 * MiB;
constexpr size_t WS_ATT = 192 * MiB;
constexpr size_t WS_Q8 = 256 * MiB;
constexpr size_t WS_K8 = 272 * MiB;
constexpr size_t WS_VT8 = 280 * MiB;
constexpr size_t WS_WG = 384 * MiB;
constexpr size_t WS_WU = 640 * MiB;
constexpr size_t WS_WD = 896 * MiB;
constexpr size_t WS_XG = 1152 * MiB;
constexpr size_t WS_H8 = 1216 * MiB;
constexpr size_t WS_ACT = 1280 * MiB;
constexpr size_t WS_EO = 1536 * MiB;
constexpr size_t WS_END = 1664 * MiB;
constexpr int CW_TMO = 0, CW_BAR = 4096;

constexpr int RING_BYTES = 131072;
constexpr int LDSCTL_OFF = 161792, MISC_OFF = LDSCTL_OFF + 320;
constexpr int LDS_BYTES = 163840;
constexpr int NWAVES = 8;

#define GAS __attribute__((address_space(1)))
#define LAS __attribute__((address_space(3)))
typedef unsigned short bf16;
typedef unsigned v4u __attribute__((ext_vector_type(4)));
typedef unsigned v2u __attribute__((ext_vector_type(2)));
typedef float f32x4 __attribute__((ext_vector_type(4)));
typedef GAS unsigned gu32;
#define RLX_AGENT __ATOMIC_RELAXED, __HIP_MEMORY_SCOPE_AGENT
#define LDS_WAIT() asm volatile("s_waitcnt lgkmcnt(0)" ::: "memory")
#define VM_WAIT() asm volatile("s_waitcnt vmcnt(0)" ::: "memory")
__device__ __forceinline__ unsigned cvt_pk_bf16(float lo, float hi) { unsigned r; asm volatile("v_cvt_pk_bf16_f32 %0, %1, %2" : "=v"(r) : "v"(lo), "v"(hi)); return r; }
__device__ __forceinline__ float clamp8(float v) { return __builtin_amdgcn_fmed3f(v, -448.f, 448.f); }
__device__ __forceinline__ unsigned pk4_fp8(float a, float b, float c, float d) {
    int w = 0; w = __builtin_amdgcn_cvt_pk_fp8_f32(clamp8(a), clamp8(b), w, false); w = __builtin_amdgcn_cvt_pk_fp8_f32(clamp8(c), clamp8(d), w, true); return (unsigned)w; }
__device__ __forceinline__ unsigned pk4_fp8_nc(float a, float b, float c, float d) { int w = 0; w = __builtin_amdgcn_cvt_pk_fp8_f32(a, b, w, false); w = __builtin_amdgcn_cvt_pk_fp8_f32(c, d, w, true); return (unsigned)w; }
__device__ __forceinline__ float bf_lo(unsigned w) { return __uint_as_float(w << 16); }
__device__ __forceinline__ float bf_hi(unsigned w) { return __uint_as_float(w & 0xffff0000u); }
__device__ __forceinline__ float wave_sum(float v) {
#pragma unroll
    for (int o = 1; o < 64; o <<= 1) v += __shfl_xor(v, o);
    return v;
}

namespace pg8 {
#define PG8_LAS __attribute__((address_space(3)))
typedef unsigned short bf16_t;
typedef short bf16x8 __attribute__((ext_vector_type(8)));
typedef float f32x4 __attribute__((ext_vector_type(4)));
typedef unsigned u32x4 __attribute__((ext_vector_type(4)));
typedef unsigned u32x2 __attribute__((ext_vector_type(2)));
typedef int i32x4 __attribute__((ext_vector_type(4)));
typedef int i32x8 __attribute__((ext_vector_type(8)));
constexpr int BM = 256, BK = 64, HALF = 128, HTB = HALF * BK * 2, STAGE_BYTES = 8 * HTB, NXCD = 8, WGM = 8;

__host__ __device__ __forceinline__ int lds_byte(int r, int c) { const int st = (r >> 4) * 2 + (c >> 5), rr = r & 15, cc = c & 31, ob = rr * 64 + cc * 2; return st * 1024 + (ob ^ (((ob >> 9) & 1) << 5)); }
__host__ __device__ __forceinline__ void stage_rc(int b, int& R, int& C) { const int st = b / 1024, sb = b % 1024, swz = sb ^ (((sb >> 9) & 1) << 5); R = (st >> 1) * 16 + swz / 64; C = (st & 1) * 32 + (swz % 64) / 2; }
__host__ __device__ __forceinline__ int perm32(int rho) { const int n = rho >> 4, i = rho & 15; return 8 * (i >> 2) + 4 * n + (i & 3); }

struct Unit { int pm, pn; };
struct Gemm { const bf16_t* A; const bf16_t* Bt; int K, nM, nN; size_t bh, bt, be; const int* gidx; PG8_LAS int* gtab; };

struct StaticOrder {
    int nM, nN, nwg, G, c, i0 = 0, ni = 1 << 30;
    __host__ __device__ void init(int nM_, int nN_, int G_, int c_) { nM = nM_; nN = nN_; nwg = nM * nN; G = G_; c = c_; }
    __host__ __device__ bool next(int i, Unit& u) const {
        if (i >= ni) return false;
        const long L = (long)(i + i0) * G + c; if (L >= nwg) return false;
        int wgid = (int)L; { const int q = nwg / NXCD, r = nwg % NXCD, xcd = wgid % NXCD, off = wgid / NXCD; wgid = (xcd < r ? xcd * (q + 1) : r * (q + 1) + (xcd - r) * q) + off; }
        const int nig = WGM * nN, gid = wgid / nig, fm = gid * WGM, gsz = (nM - fm) < WGM ? (nM - fm) : WGM;
        u.pm = fm + ((wgid % nig) % gsz); u.pn = (wgid % nig) / gsz; return true;
    }
    __device__ __forceinline__ void a_ready(const Unit&) const {}
    __device__ __forceinline__ void done(const Unit&) const {}
};

struct EpiBf16 {
    static constexpr bool PERM = true, HEADSPLIT = false, HAS_PRE = false;
    bf16_t* O; int ldc; float sc;
    __device__ __forceinline__ void operator()(const f32x4 (&acc)[2][2][4][2], const Unit& u, int wr, int wc, int fr, int fq) const {
        const int row0 = u.pm * BM + wr * 64 + fr, col0 = u.pn * BM + wc * 32 + 8 * fq;
#pragma unroll
        for (int ai = 0; ai < 2; ++ai)
#pragma unroll
            for (int m = 0; m < 4; ++m) { bf16_t* rowp = O + (size_t)(row0 + ai * HALF + m * 16) * ldc + col0;
#pragma unroll
                for (int bj = 0; bj < 2; ++bj) { const f32x4 v0 = acc[ai][bj][m][0] * sc, v1 = acc[ai][bj][m][1] * sc;
                    u32x4 w; w.x = cvt_pk_bf16(v0[0], v0[1]); w.y = cvt_pk_bf16(v0[2], v0[3]); w.z = cvt_pk_bf16(v1[0], v1[1]); w.w = cvt_pk_bf16(v1[2], v1[3]);
                    *(u32x4*)(rowp + bj * HALF) = w; } }
    }
};
struct EpiX1 {
    static constexpr bool PERM = true, HEADSPLIT = false, HAS_PRE = false;
    bf16_t* O; const float* X; int ldc; float sc;
    __device__ __forceinline__ void operator()(const f32x4 (&acc)[2][2][4][2], const Unit& u, int wr, int wc, int fr, int fq) const {
        const int row0 = u.pm * BM + wr * 64 + fr, col0 = u.pn * BM + wc * 32 + 8 * fq;
#pragma unroll
        for (int ai = 0; ai < 2; ++ai) {
            f32x4 xv[4][2][2];
#pragma unroll
            for (int m = 0; m < 4; ++m)
#pragma unroll
                for (int bj = 0; bj < 2; ++bj) { const float* xp = X + (size_t)(row0 + ai * HALF + m * 16) * ldc + col0 + bj * HALF;
                    xv[m][bj][0] = __builtin_nontemporal_load((const f32x4*)xp); xv[m][bj][1] = __builtin_nontemporal_load((const f32x4*)(xp + 4)); }
#pragma unroll
            for (int m = 0; m < 4; ++m) { bf16_t* rowp = O + (size_t)(row0 + ai * HALF + m * 16) * ldc + col0;
#pragma unroll
                for (int bj = 0; bj < 2; ++bj) { const f32x4 v0 = acc[ai][bj][m][0] * sc + xv[m][bj][0], v1 = acc[ai][bj][m][1] * sc + xv[m][bj][1];
                    u32x4 w; w.x = cvt_pk_bf16(v0[0], v0[1]); w.y = cvt_pk_bf16(v0[2], v0[3]); w.z = cvt_pk_bf16(v1[0], v1[1]); w.w = cvt_pk_bf16(v1[2], v1[3]);
                    *(u32x4*)(rowp + bj * HALF) = w; } }
        }
    }
};
typedef _Float16 h2 __attribute__((ext_vector_type(2)));
struct EpiProj {
    static constexpr bool PERM = true, HEADSPLIT = true, HAS_PRE = false;
    bf16_t* O; int ldc; const float* gq; const float* gk; PG8_LAS float* xch; const PG8_LAS float* ropetab;
    float sc;
    unsigned char* Q8; unsigned char* K8; unsigned char* VT8;
    __device__ __forceinline__ void operator()(const f32x4 (&acc)[2][2][4][2], const Unit& u, int wr, int wc, int fr, int fq) const {
        const int row0 = u.pm * BM + wr * 64 + fr, col0 = u.pn * BM + 128 * (wc >> 1) + 64 * (wc & 1) + 8 * fq;
        const bool rope = u.pn >= COL_QB / BM && u.pn < COL_VB / BM;
        if (u.pn == COL_VB / BM) {
            unsigned char* vbase = VT8 + ((size_t)(((u.pm >> 4) * 2 + (wc >> 1)) * HD + 64 * (wc & 1))) * SEQ;
            const unsigned loff = (unsigned)(8 * fq) * SEQ + (unsigned)((u.pm & 15) * BM + wr * 64 + fr);
#pragma unroll
            for (int ai = 0; ai < 2; ++ai)
#pragma unroll
                for (int m = 0; m < 4; ++m) {
#pragma unroll
                    for (int bj = 0; bj < 2; ++bj)
#pragma unroll
                        for (int n = 0; n < 2; ++n) { const f32x4 x = acc[ai][bj][m][n] * (QS * sc); const unsigned w = pk4_fp8(x[0], x[1], x[2], x[3]);
#pragma unroll
                            for (int e = 0; e < 4; ++e) vbase[(size_t)(32 * bj + 4 * n + e) * SEQ + (loff + (unsigned)(ai * HALF + m * 16))] = (unsigned char)(w >> (8 * e)); }
                    asm volatile("" ::: "memory"); }
            return;
        }
        if (!rope) {
#pragma unroll
            for (int ai = 0; ai < 2; ++ai)
#pragma unroll
                for (int m = 0; m < 4; ++m) { bf16_t* rowp = O + (size_t)(row0 + ai * HALF + m * 16) * ldc + col0;
#pragma unroll
                    for (int bj = 0; bj < 2; ++bj) { const f32x4 v0 = acc[ai][bj][m][0] * sc, v1 = acc[ai][bj][m][1] * sc;
                        u32x4 w; w.x = cvt_pk_bf16(v0[0], v0[1]); w.y = cvt_pk_bf16(v0[2], v0[3]); w.z = cvt_pk_bf16(v1[0], v1[1]); w.w = cvt_pk_bf16(v1[2], v1[3]);
                        *(u32x4*)(rowp + bj * 32) = w; } }
            return;
        }
        const int half = wc & 1;
        float ssq[2][4];
#pragma unroll
        for (int ai = 0; ai < 2; ++ai)
#pragma unroll
            for (int m = 0; m < 4; ++m) { float q = 0.f;
#pragma unroll
                for (int bj = 0; bj < 2; ++bj)
#pragma unroll
                    for (int n = 0; n < 2; ++n) { const f32x4 x = acc[ai][bj][m][n]; q += (x[0] * x[0] + x[1] * x[1]) + (x[2] * x[2] + x[3] * x[3]); }
                q += __shfl_xor(q, 16); q += __shfl_xor(q, 32); ssq[ai][m] = q;
                if (fq == 0) xch[(ai * HALF + wr * 64 + m * 16 + fr) * 4 + wc] = q; }
        asm volatile("s_waitcnt lgkmcnt(0)" ::: "memory"); __builtin_amdgcn_s_barrier(); asm volatile("" ::: "memory");
        const float* g = (u.pn >= COL_KB / BM) ? gk : gq;
        const f32x4 g1a = *(const f32x4*)(g + 64 * half + 8 * fq), g1b = *(const f32x4*)(g + 64 * half + 8 * fq + 4), g2a = *(const f32x4*)(g + 64 * half + 32 + 8 * fq), g2b = *(const f32x4*)(g + 64 * half + 32 + 8 * fq + 4);
#pragma unroll
        for (int ai = 0; ai < 2; ++ai)
#pragma unroll
            for (int m = 0; m < 4; ++m) {
                const int rl = ai * HALF + wr * 64 + m * 16 + fr, row = u.pm * BM + rl, srow = row & (SEQ - 1);
                const float tot = ssq[ai][m] + xch[rl * 4 + (wc ^ 1)];
                const float rstd = sc / sqrtf(tot * (sc * sc * (1.f / HD)) + EPS);
                const int pos = half ? (srow & 63) : (srow >> 6);
                const PG8_LAS f32x4* tb = (const PG8_LAS f32x4*)(ropetab + (pos * 32 + 8 * fq) * 2);
                f32x4 o1[2], o2[2];
#pragma unroll
                for (int n = 0; n < 2; ++n) { const f32x4 ga = n ? g1b : g1a, gb = n ? g2b : g2a; const f32x4 t0 = tb[2 * n], t1 = tb[2 * n + 1];
#pragma unroll
                    for (int e = 0; e < 4; ++e) { const float cs = (e < 2 ? t0 : t1)[2 * (e & 1)], sn = (e < 2 ? t0 : t1)[2 * (e & 1) + 1];
                        const float y1 = acc[ai][0][m][n][e] * rstd * ga[e], y2 = acc[ai][1][m][n][e] * rstd * gb[e];
                        o1[n][e] = y1 * cs - y2 * sn; o2[n][e] = y2 * cs + y1 * sn; } }
                unsigned char* rowp = (u.pn >= COL_KB / BM) ? K8 + (size_t)row * 256 + 128 * (wc >> 1) + 64 * half + 8 * fq
                                                            : Q8 + (size_t)row * 1024 + 128 * ((u.pn - COL_QB / BM) * 2 + (wc >> 1)) + 64 * half + 8 * fq;
                const float qs = (u.pn >= COL_KB / BM) ? QS : QSQ;
                u32x2 w; w.x = pk4_fp8(o1[0][0] * qs, o1[0][1] * qs, o1[0][2] * qs, o1[0][3] * qs); w.y = pk4_fp8(o1[1][0] * qs, o1[1][1] * qs, o1[1][2] * qs, o1[1][3] * qs);
                *(u32x2*)rowp = w;
                w.x = pk4_fp8(o2[0][0] * qs, o2[0][1] * qs, o2[0][2] * qs, o2[0][3] * qs); w.y = pk4_fp8(o2[1][0] * qs, o2[1][1] * qs, o2[1][2] * qs, o2[1][3] * qs);
                *(u32x2*)(rowp + 32) = w; }
    }
};
struct EpiResF32 {
    static constexpr bool PERM = false, HEADSPLIT = false, HAS_PRE = false;
    const float* base; float* C; int ldc;
    __device__ __forceinline__ void operator()(const f32x4 (&acc)[2][2][4][2], const Unit& u, int wr, int wc, int fr, int fq) const {
        const int row0 = u.pm * BM + wr * 64 + fr, col0 = u.pn * BM + wc * 32 + 4 * fq;
#pragma unroll
        for (int ai = 0; ai < 2; ++ai)
#pragma unroll
            for (int m = 0; m < 4; ++m) { const size_t off = (size_t)(row0 + ai * HALF + m * 16) * ldc + col0;
#pragma unroll
                for (int bj = 0; bj < 2; ++bj)
#pragma unroll
                    for (int n = 0; n < 2; ++n) { const f32x4 bs = *(const f32x4*)(base + off + bj * HALF + n * 16); *(f32x4*)(C + off + bj * HALF + n * 16) = bs + acc[ai][bj][m][n]; }
                asm volatile("" ::: "memory"); }
    }
};
__device__ __forceinline__ float silu_mul(float a, float u) { return a * u * __builtin_amdgcn_rcpf(1.0f + __builtin_amdgcn_exp2f(-1.4426950408889634f * a)); }
struct EpiSwiGlu8 {
    static constexpr bool PERM = true, HEADSPLIT = false, HAS_PRE = true;
    unsigned char* O; int ldc; float si, so; const float* rs;
    __device__ __forceinline__ void prefetch(const Unit& u, float (&pre)[8], int wr, int fr) const {
        const int row0 = u.pm * BM + wr * 64 + fr;
#pragma unroll
        for (int ai = 0; ai < 2; ++ai)
#pragma unroll
            for (int m = 0; m < 4; ++m) pre[ai * 4 + m] = rs[row0 + ai * HALF + m * 16];
    }
    __device__ __forceinline__ void operator()(const f32x4 (&acc)[2][2][4][2], const Unit& u, int wr, int wc, int fr, int fq, const float (&pre)[8]) const {
        const int row0 = u.pm * BM + wr * 64 + fr, col0 = u.pn * HALF + wc * 32 + 8 * fq;
#pragma unroll
        for (int ai = 0; ai < 2; ++ai)
#pragma unroll
            for (int m = 0; m < 4; ++m) { const int row = row0 + ai * HALF + m * 16; unsigned char* rowp = O + (size_t)row * ldc + col0;
                const float sg = si * pre[ai * 4 + m], k1 = -1.4426950408889634f * sg, k2 = sg * sg * so;
                float r[8];
#pragma unroll
                for (int n = 0; n < 2; ++n)
#pragma unroll
                    for (int e = 0; e < 4; ++e) { const float gg = acc[ai][0][m][n][e], uu = acc[ai][1][m][n][e];
                        r[4 * n + e] = (gg * uu) * (k2 * __builtin_amdgcn_rcpf(1.0f + __builtin_amdgcn_exp2f(k1 * gg))); }
                u32x2 w; w.x = pk4_fp8(r[0], r[1], r[2], r[3]); w.y = pk4_fp8(r[4], r[5], r[6], r[7]);
                *(u32x2*)rowp = w; }
    }
};

template <class Epi, class Sched, bool ALIGN_EPI = false, bool SP2 = false, bool FP8 = false, bool GATHER = false>
__device__ __forceinline__ void gemm_phase(PG8_LAS unsigned char* lds, const Gemm g, const Sched& S, const Epi& E) {
    int tid = threadIdx.x; asm volatile("" : "+v"(tid));
    const int wid = __builtin_amdgcn_readfirstlane(tid >> 6), lane = tid & 63, wr = wid >> 2, wc = wid & 3, fr = lane & 15, fq = lane >> 4;
    const int K = g.K, nt = K / BK;
    unsigned voffA[2], voffB[2]; int stR[2], stC[2];
#pragma unroll
    for (int i = 0; i < 2; ++i) { int R, C; stage_rc(tid * 16 + i * 8192, R, C); const int Rb = Epi::HEADSPLIT ? (128 * (R >> 6) + 64 * ((R >> 5) & 1) + perm32(R & 31)) : (Epi::PERM ? ((R & ~31) + perm32(R & 31)) : R);
        voffA[i] = (unsigned)(R * K + C) * 2u; voffB[i] = (unsigned)(Rb * K + C) * 2u; stR[i] = R; stC[i] = C; }
    const size_t kstep = (size_t)(BK * 2);
    const size_t hA = (size_t)HALF * K * 2, hB = g.bh;
    const size_t tstepA = 2 * hA;
    const unsigned ldsw = (unsigned)wid * 1024u;
    const int aoff = lds_byte(wr * 64 + fr, fq * 8), boff = lds_byte(wc * 32 + fr, fq * 8);
#define PG8_SA(b, h) (((b) * 2 + (h)) * HTB)
#define PG8_SB(b, h) ((4 + (b) * 2 + (h)) * HTB)
#define PG8_STAGE(bufoff, gbase, voff) do { _Pragma("unroll") for (int _i = 0; _i < 2; ++_i) \
        __builtin_amdgcn_global_load_lds((const unsigned*)((const char*)(gbase) + (voff)[_i]), (PG8_LAS unsigned*)(lds + (bufoff) + ldsw + _i * 8192), 16, 0, 0); } while (0)
#define PG8_LDA(dst, b, h) do { _Pragma("unroll") for (int m = 0; m < 4; ++m) _Pragma("unroll") for (int k = 0; k < 2; ++k) dst[m][k] = *(const PG8_LAS bf16x8*)(lds + PG8_SA(b, h) + aoff + m * 2048 + k * 1024); } while (0)
#define PG8_LDB(dst, b, h) do { _Pragma("unroll") for (int n = 0; n < 2; ++n) _Pragma("unroll") for (int k = 0; k < 2; ++k) dst[n][k] = *(const PG8_LAS bf16x8*)(lds + PG8_SB(b, h) + boff + n * 2048 + k * 1024); } while (0)
#define PG8_CAT(x) __builtin_shufflevector(__builtin_bit_cast(i32x4, (x)[0]), __builtin_bit_cast(i32x4, (x)[1]), 0, 1, 2, 3, 4, 5, 6, 7)
#define PG8_MMA(ai, bj, At, Bt) do { __builtin_amdgcn_s_setprio(1); _Pragma("unroll") for (int m = 0; m < 4; ++m) _Pragma("unroll") for (int n = 0; n < 2; ++n) { \
        if constexpr (FP8) { asm volatile("v_mfma_scale_f32_16x16x128_f8f6f4 %0, %1, %2, %0, %3, %3 op_sel_hi:[0,0,0]" : "+v"(acc[ai][bj][m][n]) : "v"(PG8_CAT(Bt[n])), "v"(PG8_CAT(At[m])), "v"(unit_scale)); } \
        else { _Pragma("unroll") for (int k = 0; k < 2; ++k) acc[ai][bj][m][n] = __builtin_amdgcn_mfma_f32_16x16x32_bf16(Bt[n][k], At[m][k], acc[ai][bj][m][n], 0, 0, 0); } } \
        __builtin_amdgcn_s_setprio(0); } while (0)
#define PG8_WAIT_V(n) asm volatile("s_waitcnt vmcnt(" #n ")" ::: "memory")
#define PG8_WAIT_L(n) asm volatile("s_waitcnt lgkmcnt(" #n ")" ::: "memory")
#define PG8_BAR __builtin_amdgcn_s_barrier()
#define PG8_SCHED __builtin_amdgcn_sched_barrier(0)
    Unit cur, nxt; int ui = 0;
    if (!S.next(0, cur)) return;
    const int unit_scale = 0x7f7f7f7f; (void)unit_scale;
    f32x4 acc[2][2][4][2];
#pragma unroll
    for (int a = 0; a < 2; ++a)
#pragma unroll
        for (int b = 0; b < 2; ++b)
#pragma unroll
            for (int m = 0; m < 4; ++m)
#pragma unroll
                for (int n = 0; n < 2; ++n) acc[a][b][m][n] = (f32x4){0.f, 0.f, 0.f, 0.f};
    bf16x8 At[4][2], B0[2][2], B1[2][2];
    const char* cA = GATHER ? (const char*)g.A : (const char*)g.A + (size_t)cur.pm * tstepA; const char* cB = (const char*)g.Bt + (size_t)(cur.pm >> 3) * g.be + (size_t)cur.pn * g.bt;
    S.a_ready(cur);
    unsigned gc[2][2], gn[2][2];
    if constexpr (GATHER) {
#pragma unroll
        for (int h = 0; h < 2; ++h)
#pragma unroll
            for (int i = 0; i < 2; ++i) { const int tok = g.gidx[cur.pm * BM + h * HALF + stR[i]]; gc[h][i] = (unsigned)(((((cur.pm >> 1) & 3) * SEQ + tok) * K + stC[i]) * 2); gn[h][i] = gc[h][i]; }
    }
#define PG8_OA(h, nx) (GATHER ? ((nx) ? gn[h] : gc[h]) : voffA)
#define PG8_HA(h) (GATHER ? (size_t)0 : (size_t)(h) * hA)
    float pre[8]; (void)pre;
    if constexpr (Epi::HAS_PRE) E.prefetch(cur, pre, wr, fr);
    if constexpr (SP2) {
        PG8_STAGE(PG8_SB(0, 0), cB, voffB); PG8_STAGE(PG8_SB(0, 1), cB + hB, voffB); PG8_STAGE(PG8_SA(0, 0), cA, PG8_OA(0, false)); PG8_STAGE(PG8_SA(0, 1), cA + PG8_HA(1), PG8_OA(1, false));
        if (wr == 1) PG8_BAR;
        PG8_WAIT_V(2); PG8_BAR;
        PG8_STAGE(PG8_SB(1, 0), cB + kstep, voffB); PG8_STAGE(PG8_SA(1, 0), cA + kstep, PG8_OA(0, false)); PG8_STAGE(PG8_SB(1, 1), cB + hB + kstep, voffB);
        PG8_WAIT_V(6); PG8_BAR;
    } else {
        PG8_STAGE(PG8_SB(0, 0), cB, voffB); PG8_STAGE(PG8_SA(0, 0), cA, PG8_OA(0, false)); PG8_STAGE(PG8_SB(0, 1), cB + hB, voffB); PG8_STAGE(PG8_SA(0, 1), cA + PG8_HA(1), PG8_OA(1, false));
        if (wr == 1) PG8_BAR;
        PG8_WAIT_V(4); PG8_BAR;
        PG8_STAGE(PG8_SB(1, 0), cB + kstep, voffB); PG8_STAGE(PG8_SA(1, 0), cA + kstep, PG8_OA(0, false)); PG8_STAGE(PG8_SB(1, 1), cB + hB + kstep, voffB);
        PG8_WAIT_V(6); PG8_BAR;
    }
    for (;;) {
        const bool has_next = S.next(ui + 1, nxt);
        if constexpr (GATHER) { if (has_next && wid == 0)
            __builtin_amdgcn_global_load_lds((const unsigned*)(g.gidx + nxt.pm * BM + lane * 4), (PG8_LAS unsigned*)(g.gtab + ((ui + 1) & 1) * BM), 16, 0, 0); }
        const char* nA = GATHER ? cA : (has_next ? (const char*)g.A + (size_t)nxt.pm * tstepA : cA); const char* nB = has_next ? (const char*)g.Bt + (size_t)(nxt.pm >> 3) * g.be + (size_t)nxt.pn * g.bt : cB;
        for (int t = 0; t < nt; t += 2) {
            const bool last = (t == nt - 2);
            const char* a1 = cA + (size_t)(t + 1) * kstep;
            const char* a2 = last ? nA : cA + (size_t)(t + 2) * kstep; const char* b2 = last ? nB : cB + (size_t)(t + 2) * kstep;
            const char* a3 = a2 + kstep; const char* b3 = b2 + kstep;
            if (last && has_next) S.a_ready(nxt);
            if constexpr (GATHER) { if (last && has_next) {
#pragma unroll
                for (int h = 0; h < 2; ++h)
#pragma unroll
                    for (int i = 0; i < 2; ++i) { const int tok = g.gtab[((ui + 1) & 1) * BM + h * HALF + stR[i]]; gn[h][i] = (unsigned)(((((nxt.pm >> 1) & 3) * SEQ + tok) * K + stC[i]) * 2); } } }
            if constexpr (SP2) {
            PG8_LDB(B0, 0, 0); PG8_LDB(B1, 0, 1); PG8_SCHED; PG8_LDA(At, 0, 0); PG8_STAGE(PG8_SA(1, 1), a1 + PG8_HA(1), PG8_OA(1, false));
            PG8_WAIT_V(8); PG8_WAIT_L(0); PG8_BAR; PG8_MMA(0, 0, At, B0); PG8_MMA(0, 1, At, B1); PG8_BAR; PG8_SCHED;
            PG8_LDA(At, 0, 1); PG8_STAGE(PG8_SB(0, 0), b2, voffB); PG8_STAGE(PG8_SB(0, 1), b2 + hB, voffB); PG8_STAGE(PG8_SA(0, 0), a2, PG8_OA(0, last));
            PG8_WAIT_V(8); PG8_WAIT_L(0); PG8_BAR; PG8_MMA(1, 0, At, B0); PG8_MMA(1, 1, At, B1); PG8_BAR; PG8_SCHED;
            PG8_LDB(B0, 1, 0); PG8_LDB(B1, 1, 1); PG8_SCHED; PG8_LDA(At, 1, 0); PG8_STAGE(PG8_SA(0, 1), a2 + PG8_HA(1), PG8_OA(1, last));
            PG8_WAIT_V(8); PG8_WAIT_L(0); PG8_BAR; PG8_MMA(0, 0, At, B0); PG8_MMA(0, 1, At, B1); PG8_BAR; PG8_SCHED;
            PG8_LDA(At, 1, 1); PG8_STAGE(PG8_SB(1, 0), b3, voffB); PG8_STAGE(PG8_SB(1, 1), b3 + hB, voffB); PG8_STAGE(PG8_SA(1, 0), a3, PG8_OA(0, last));
            PG8_WAIT_V(8); PG8_WAIT_L(0); PG8_BAR; PG8_MMA(1, 0, At, B0); PG8_MMA(1, 1, At, B1); PG8_BAR; PG8_SCHED;
            } else {
            PG8_LDB(B0, 0, 0); PG8_SCHED; PG8_LDA(At, 0, 0); PG8_STAGE(PG8_SA(1, 1), a1 + PG8_HA(1), PG8_OA(1, false));
            PG8_WAIT_L(8); PG8_BAR; PG8_WAIT_L(0); PG8_MMA(0, 0, At, B0); PG8_BAR; PG8_SCHED;
            PG8_LDB(B1, 0, 1); PG8_STAGE(PG8_SB(0, 0), b2, voffB);
            PG8_BAR; PG8_WAIT_L(0); PG8_MMA(0, 1, At, B1); PG8_BAR;
            PG8_LDA(At, 0, 1); PG8_STAGE(PG8_SA(0, 0), a2, PG8_OA(0, last));
            PG8_BAR; PG8_WAIT_L(0); PG8_MMA(1, 0, At, B0); PG8_BAR; PG8_SCHED;
            PG8_STAGE(PG8_SB(0, 1), b2 + hB, voffB);
            PG8_WAIT_V(6); PG8_BAR; PG8_MMA(1, 1, At, B1); PG8_BAR;
            PG8_LDB(B0, 1, 0); PG8_SCHED; PG8_LDA(At, 1, 0); PG8_STAGE(PG8_SA(0, 1), a2 + PG8_HA(1), PG8_OA(1, last));
            PG8_WAIT_L(8); PG8_BAR; PG8_WAIT_L(0); PG8_MMA(0, 0, At, B0); PG8_BAR; PG8_SCHED;
            PG8_LDB(B1, 1, 1); PG8_STAGE(PG8_SB(1, 0), b3, voffB);
            PG8_BAR; PG8_WAIT_L(0); PG8_MMA(0, 1, At, B1); PG8_BAR;
            PG8_LDA(At, 1, 1); PG8_STAGE(PG8_SA(1, 0), a3, PG8_OA(0, last));
            PG8_BAR; PG8_WAIT_L(0); PG8_MMA(1, 0, At, B0); PG8_BAR; PG8_SCHED;
            PG8_STAGE(PG8_SB(1, 1), b3 + hB, voffB);
            PG8_WAIT_V(6); PG8_BAR; PG8_MMA(1, 1, At, B1); PG8_BAR;
            }
        }
        if constexpr (ALIGN_EPI) { if (wr == 0) PG8_BAR; }
        if constexpr (FP8) asm volatile("s_nop 15\n\ts_nop 15" ::: "memory");
        if constexpr (Epi::HAS_PRE) E(acc, cur, wr, wc, fr, fq, pre); else E(acc, cur, wr, wc, fr, fq);
        S.done(cur);
        if (!has_next) break;
#pragma unroll
        for (int a = 0; a < 2; ++a)
#pragma unroll
            for (int b = 0; b < 2; ++b)
#pragma unroll
                for (int m = 0; m < 4; ++m)
#pragma unroll
                    for (int n = 0; n < 2; ++n) acc[a][b][m][n] = (f32x4){0.f, 0.f, 0.f, 0.f};
        cur = nxt; cA = nA; cB = nB; ++ui;
        if constexpr (GATHER) { gc[0][0] = gn[0][0]; gc[0][1] = gn[0][1]; gc[1][0] = gn[1][0]; gc[1][1] = gn[1][1]; }
        if constexpr (Epi::HAS_PRE) E.prefetch(cur, pre, wr, fr);
        if constexpr (ALIGN_EPI) { if (wr == 1) PG8_BAR; }
    }
    PG8_WAIT_V(0);
    if constexpr (!ALIGN_EPI) { if (wr == 0) PG8_BAR; }
    PG8_BAR;
#undef PG8_OA
#undef PG8_HA
#undef PG8_SA
#undef PG8_SB
#undef PG8_STAGE
#undef PG8_LDA
#undef PG8_LDB
#undef PG8_MMA
#undef PG8_CAT
#undef PG8_WAIT_V
#undef PG8_WAIT_L
#undef PG8_BAR
#undef PG8_SCHED
}
}

namespace att {
constexpr int D = 128, NW = 8, QBLK = 32, KVBLK = 64;
constexpr float SCALE = 0.088388347648318440f;
constexpr float THR = 8.f;
constexpr int LDQ = DIN, LDK = DIN, LDO = DM;
constexpr size_t SHM_V = KVBLK * D * 2, SHM_K = KVBLK * D * 2, SHM_ATTN = 2 * SHM_V + 2 * SHM_K + NW * 64 * 4;
using bf16x8 = __attribute__((ext_vector_type(8))) short;
using s16x4  = __attribute__((ext_vector_type(4))) short;
using f32x16 = __attribute__((ext_vector_type(16))) float;
using u32x4  = __attribute__((ext_vector_type(4))) unsigned;
#define KSWZ(row, colB) ((row) * 256 + ((colB) ^ (((row) & 7) << 4)))
#define SBAR() __builtin_amdgcn_sched_barrier(0)
__device__ __forceinline__ int crow(int r, int hi) { return (r & 3) + 8 * (r >> 2) + 4 * hi; }
__device__ __forceinline__ unsigned cvtpk(float lo, float hi) { unsigned r; asm volatile("v_cvt_pk_bf16_f32 %0, %1, %2" : "=v"(r) : "v"(lo), "v"(hi)); return r; }
__device__ __forceinline__ bf16x8 ld8(const bf16* p) { return *reinterpret_cast<const bf16x8*>(p); }

template <bool WIN>
__device__ __forceinline__ void partialSM(f32x16& p0, f32x16& p1, float& m_reg, float& mn, float& alpha, float fdb, float nslope) {
  constexpr float C = SCALE * 1.4426950408889634f;
  if constexpr (WIN) {
#pragma unroll
    for (int r = 0; r < 16; ++r) { const float cr = (float)((r & 3) + 8 * (r >> 2));
      const float d0 = __builtin_fabsf(fdb - cr), d1 = __builtin_fabsf(fdb - 32.f - cr);
      p0[r] = d0 <= 128.f ? fmaf(nslope, d0, p0[r]) : -1e30f;
      p1[r] = d1 <= 128.f ? fmaf(nslope, d1, p1[r]) : -1e30f; }
  }
  float pmax = p0[0]; for (int r = 1; r < 16; ++r) pmax = fmaxf(pmax, p0[r]); for (int r = 0; r < 16; ++r) pmax = fmaxf(pmax, p1[r]);
  { auto rr = __builtin_amdgcn_permlane32_swap(__float_as_uint(pmax), __float_as_uint(pmax), false, false);
    pmax = fmaxf(__uint_as_float(rr[0]), __uint_as_float(rr[1])); }
  if (__builtin_expect(__all(pmax - m_reg <= THR / SCALE), 1)) { mn = m_reg; alpha = 1.f; }
  else { mn = fmaxf(m_reg, pmax); alpha = __builtin_amdgcn_exp2f((m_reg - mn) * C); m_reg = mn; }
  float mnC = -mn * C;
  for (int r = 0; r < 16; ++r) p0[r] = fmaf(p0[r], C, mnC); for (int r = 0; r < 16; ++r) p1[r] = fmaf(p1[r], C, mnC);
  for (int r = 0; r < 16; ++r) p0[r] = __builtin_amdgcn_exp2f(p0[r]);
}
__device__ __forceinline__ void finishSM(f32x16& p0, f32x16& p1, float alpha, float& l_reg, bf16x8& pa0, bf16x8& pa1, bf16x8& pa2, bf16x8& pa3) {
  for (int r = 0; r < 16; ++r) p1[r] = __builtin_amdgcn_exp2f(p1[r]);
  float ps = 0; for (int r = 0; r < 16; ++r) ps += p0[r]; for (int r = 0; r < 16; ++r) ps += p1[r];
  { auto rr = __builtin_amdgcn_permlane32_swap(__float_as_uint(ps), __float_as_uint(ps), false, false);
    ps = __uint_as_float(rr[0]) + __uint_as_float(rr[1]); }
  l_reg = l_reg * alpha + ps;
#define PK4(P, BASE, OUT) do { unsigned a0 = cvtpk(P[BASE + 0], P[BASE + 1]), a1 = cvtpk(P[BASE + 2], P[BASE + 3]);   \
    unsigned b0 = cvtpk(P[BASE + 4], P[BASE + 5]), b1 = cvtpk(P[BASE + 6], P[BASE + 7]);                              \
    auto r0 = __builtin_amdgcn_permlane32_swap(a0, b0, false, false); auto r1 = __builtin_amdgcn_permlane32_swap(a1, b1, false, false); \
    u32x4 w = {r0[0], r1[0], r0[1], r1[1]}; OUT = *reinterpret_cast<bf16x8*>(&w); } while (0)
  PK4(p0, 0, pa0); PK4(p0, 8, pa1); PK4(p1, 0, pa2); PK4(p1, 8, pa3);
#undef PK4
}
__device__ __forceinline__ void qkt(f32x16& p0, f32x16& p1, const bf16* Ks, const bf16x8* qr, int r32, int hi) {
  p0 = f32x16{}; p1 = f32x16{};
  for (int d0 = 0; d0 < 8; ++d0) { int cb = (d0 * 16 + hi * 8) * 2;
    bf16x8 b0 = *reinterpret_cast<const bf16x8*>((const char*)Ks + KSWZ(r32, cb));
    bf16x8 b1 = *reinterpret_cast<const bf16x8*>((const char*)Ks + KSWZ(32 + r32, cb));
    p0 = __builtin_amdgcn_mfma_f32_32x32x16_bf16(b0, qr[d0], p0, 0, 0, 0);
    p1 = __builtin_amdgcn_mfma_f32_32x32x16_bf16(b1, qr[d0], p1, 0, 0, 0); }
}
__device__ __forceinline__ int v_st(int k, int c) { const int kk = (k & ~0xC) | ((k & 4) << 1) | ((k & 8) >> 1); return ((kk >> 3) * 4 + (c >> 5)) * 512 + ((kk & 7) * 32 + (c & 31)) * 2; }
__device__ __forceinline__ int v_rd_base(int lane) { return ((lane & 3) << 3) | (((lane >> 2) & 3) << 6) | (((lane >> 4) & 1) << 5) | (((lane >> 5) & 1) << 8); }
constexpr int v_rd_off(int d0, int ks, int half) { return d0 * 512 + ks * 4096 + half * 2048; }
template <int OFF> __device__ __forceinline__ s16x4 tr_read(int vb) {
  s16x4 r; asm volatile("ds_read_b64_tr_b16 %0, %1 offset:%2" : "=&v"(r) : "v"(vb), "i"(OFF) : "memory"); return r;
}
template <int D0> __device__ __forceinline__ void pv_one(f32x16& od, int vb, bf16x8 pa0, bf16x8 pa1, bf16x8 pa2, bf16x8 pa3) {
  const s16x4 l0 = tr_read<v_rd_off(D0, 0, 0)>(vb), h0 = tr_read<v_rd_off(D0, 0, 1)>(vb), l1 = tr_read<v_rd_off(D0, 1, 0)>(vb), h1 = tr_read<v_rd_off(D0, 1, 1)>(vb);
  const s16x4 l2 = tr_read<v_rd_off(D0, 2, 0)>(vb), h2 = tr_read<v_rd_off(D0, 2, 1)>(vb), l3 = tr_read<v_rd_off(D0, 3, 0)>(vb), h3 = tr_read<v_rd_off(D0, 3, 1)>(vb);
  asm volatile("s_waitcnt lgkmcnt(0)" ::: "memory"); SBAR();
#define PK(L, H) (bf16x8){L[0], L[1], L[2], L[3], H[0], H[1], H[2], H[3]}
  od = __builtin_amdgcn_mfma_f32_32x32x16_bf16(pa0, PK(l0, h0), od, 0, 0, 0);
  od = __builtin_amdgcn_mfma_f32_32x32x16_bf16(pa1, PK(l1, h1), od, 0, 0, 0);
  od = __builtin_amdgcn_mfma_f32_32x32x16_bf16(pa2, PK(l2, h2), od, 0, 0, 0);
  od = __builtin_amdgcn_mfma_f32_32x32x16_bf16(pa3, PK(l3, h3), od, 0, 0, 0);
#undef PK
}
__device__ __forceinline__ void pv_d0(f32x16* o, int vb, bf16x8 pa0, bf16x8 pa1, bf16x8 pa2, bf16x8 pa3) {
  pv_one<0>(o[0], vb, pa0, pa1, pa2, pa3); pv_one<1>(o[1], vb, pa0, pa1, pa2, pa3); pv_one<2>(o[2], vb, pa0, pa1, pa2, pa3); pv_one<3>(o[3], vb, pa0, pa1, pa2, pa3);
}

template <bool WIN, int SDEPTH>
__device__ __forceinline__ void attn_body(const bf16* __restrict__ Qb, const bf16* __restrict__ Kh, unsigned char* __restrict__ Ob, int NT, char* lds,
                                          int qrel0, float slope, float sink) {
  int tid = threadIdx.x; asm volatile("" : "+v"(tid));
  const int wid = tid >> 6, lane = tid & 63, r32 = lane & 31, hi = lane >> 5;
  bf16* V_lds = (bf16*)lds; bf16* K_lds = (bf16*)(lds + 2 * SHM_V);
  float* ws = (float*)(lds + 2 * SHM_V + 2 * SHM_K) + wid * 64; float* li_l = ws; float* al_l = ws + 32;
  float m_reg = WIN ? sink * (1.0f / SCALE) : -1e30f, l_reg = WIN ? 1.0f : 0.f; f32x16 o[4] = {}; bf16x8 qr[8];
  const float nslope = -slope * (1.0f / SCALE);
  const float fd0 = (float)(qrel0 + wid * QBLK + r32 - 4 * hi);
  const bf16* Qw = Qb + (long)(wid * QBLK + r32) * LDQ + hi * 8;
#pragma unroll
  for (int d0 = 0; d0 < 8; ++d0) qr[d0] = ld8(Qw + d0 * 16);
  const int sr = tid >> 4, sc = (tid & 15) * 8, vst0 = v_st(sr, sc), vst1 = v_st(32 + sr, sc);
  const int vb0 = (int)(uintptr_t)V_lds + v_rd_base(lane);
  struct { bf16x8 vs0, vs1, ks0, ks1; } sr_[SDEPTH];
  const unsigned loff = (unsigned)(sr * LDK + sc) * 2u;
#define SLOAD(i, k0) do { const GAS char* tb = (const GAS char*)Kh + (size_t)(k0) * (LDK * 2); const GAS char* tb2 = tb + (size_t)32 * LDK * 2; \
    sr_[i].vs0 = *(const GAS bf16x8*)(tb + loff + 512); sr_[i].vs1 = *(const GAS bf16x8*)(tb2 + loff + 512); \
    sr_[i].ks0 = *(const GAS bf16x8*)(tb + loff); sr_[i].ks1 = *(const GAS bf16x8*)(tb2 + loff); } while (0)
#define SWRITE(b, i) do { *(bf16x8*)((char*)V_lds + (b) * SHM_V + vst0) = sr_[i].vs0;          \
    *(bf16x8*)((char*)V_lds + (b) * SHM_V + vst1) = sr_[i].vs1; int kc = sc * 2;               \
    *(bf16x8*)((char*)K_lds + (b) * SHM_K + KSWZ(sr, kc)) = sr_[i].ks0;                       \
    *(bf16x8*)((char*)K_lds + (b) * SHM_K + KSWZ(32 + sr, kc)) = sr_[i].ks1; } while (0)
#define SWAIT() do { if constexpr (SDEPTH == 2) asm volatile("s_waitcnt vmcnt(4)" ::: "memory"); else asm volatile("s_waitcnt vmcnt(0)" ::: "memory"); } while (0)
#define RESC(a) do { if (__any((a) < 1.f)) { if (hi == 0) al_l[r32] = (a); asm volatile("s_waitcnt lgkmcnt(0)" ::: "memory"); \
    for (int d = 0; d < 4; ++d) for (int r = 0; r < 16; ++r) o[d][r] *= al_l[crow(r, hi)]; } } while (0)
  f32x16 pA0, pA1, pB0, pB1; float mnA, mnB, alA, alB; bf16x8 pa0, pa1, pa2, pa3;
  constexpr int SE = 0, SO = SDEPTH - 1;
  const int wq0 = WIN ? __builtin_amdgcn_readfirstlane(qrel0 + wid * QBLK) : 0;
#define NEED(t) (!WIN || (64 * (t) <= wq0 + 159 && 64 * (t) + 63 >= wq0 - 128))
  bool nA = NEED(0), nB = true;
  SLOAD(SE, 0); asm volatile("s_waitcnt vmcnt(0)" ::: "memory"); SWRITE(0, SE); __syncthreads();
  if (nA) { qkt(pA0, pA1, K_lds, qr, r32, hi); partialSM<WIN>(pA0, pA1, m_reg, mnA, alA, fd0, nslope); }
  SLOAD(SO, KVBLK); if constexpr (SDEPTH == 2) { if (2 < NT) SLOAD(SE, 2 * KVBLK); }
  SWAIT(); SWRITE(1, SO); __syncthreads();
  for (int j = 1; j + 1 < NT; j += 2) {
    nB = NEED(j);
    SBAR(); if (nB) qkt(pB0, pB1, (bf16*)((char*)K_lds + SHM_K), qr, r32, hi);
    if (nA) finishSM(pA0, pA1, alA, l_reg, pa0, pa1, pa2, pa3); SBAR();
    SLOAD(SO, (j + SDEPTH) * KVBLK); SBAR();
    if (nA) pv_d0(o, vb0, pa0, pa1, pa2, pa3); if (nB) partialSM<WIN>(pB0, pB1, m_reg, mnB, alB, fd0 - 64.f * (float)j, nslope);
    __syncthreads(); SWAIT(); SWRITE(0, SE);
    if (nB) RESC(alB); __syncthreads();
    nA = NEED(j + 1);
    SBAR(); if (nA) qkt(pA0, pA1, K_lds, qr, r32, hi);
    if (nB) finishSM(pB0, pB1, alB, l_reg, pa0, pa1, pa2, pa3); SBAR();
    if (SDEPTH == 1 || j + 3 < NT) SLOAD(SE, (j + 1 + SDEPTH) * KVBLK); SBAR();
    if (nB) pv_d0(o, vb0 + (int)SHM_V, pa0, pa1, pa2, pa3); if (nA) partialSM<WIN>(pA0, pA1, m_reg, mnA, alA, fd0 - 64.f * (float)(j + 1), nslope);
    __syncthreads(); SWAIT(); SWRITE(1, SO);
    if (nA) RESC(alA); __syncthreads();
  }
  nB = NEED(NT - 1);
  SBAR(); if (nB) qkt(pB0, pB1, (bf16*)((char*)K_lds + SHM_K), qr, r32, hi);
  if (nA) finishSM(pA0, pA1, alA, l_reg, pa0, pa1, pa2, pa3); SBAR();
  if (nA) pv_d0(o, vb0, pa0, pa1, pa2, pa3); if (nB) partialSM<WIN>(pB0, pB1, m_reg, mnB, alB, fd0 - 64.f * (float)(NT - 1), nslope);
  __syncthreads(); if (nB) { RESC(alB);
  finishSM(pB0, pB1, alB, l_reg, pa0, pa1, pa2, pa3); SBAR();
  pv_d0(o, vb0 + (int)SHM_V, pa0, pa1, pa2, pa3); }
#undef NEED
  if (hi == 0) li_l[r32] = l_reg; asm volatile("s_waitcnt lgkmcnt(0)" ::: "memory");
  float rli[16];
#pragma unroll
  for (int r = 0; r < 16; ++r) rli[r] = __builtin_amdgcn_rcpf(li_l[crow(r, hi)]);
  unsigned char* Ow = Ob + (long)(wid * QBLK) * LDO + 4 * r32;
#pragma unroll
  for (int r = 0; r < 16; ++r) { const int orow = crow(r, hi); const float sr = rli[r] * OS;
    *(unsigned*)(Ow + (long)orow * LDO) = pk4_fp8(o[0][r] * sr, o[1][r] * sr, o[2][r] * sr, o[3][r] * sr); }
#undef SLOAD
#undef SWRITE
#undef SWAIT
#undef RESC
}

typedef int i32x8 __attribute__((ext_vector_type(8)));
typedef int i32x4 __attribute__((ext_vector_type(4)));
constexpr int SHM8 = 8192;
__device__ __forceinline__ i32x8 cat8(i32x4 a, i32x4 b) { return __builtin_shufflevector(a, b, 0, 1, 2, 3, 4, 5, 6, 7); }
__device__ __forceinline__ void mfma8(f32x16& acc, i32x8 a, i32x8 b) {
  acc = __builtin_amdgcn_mfma_scale_f32_32x32x64_f8f6f4(a, b, acc, 0, 0, 0, 0x7f7f7f7f, 0, 0x7f7f7f7f);
}
__device__ __forceinline__ void mfma8qk(f32x16& d, const f32x16& c, i32x8 a, i32x8 b) {
  d = __builtin_amdgcn_mfma_scale_f32_32x32x64_f8f6f4(a, b, c, 0, 0, 0, 0x7f7f7f7f, 0, 0x74747474);
}
template <int SDEPTH>
__device__ __forceinline__ void attn_body8(const unsigned char* __restrict__ Qb, const unsigned char* __restrict__ Kh, const unsigned char* __restrict__ VTh, unsigned char* __restrict__ Ob, int NT, char* lds) {
  constexpr float XMAX = 3.0f + 4.0f * 1.4426950408889634f;
  static_assert(PSC == 8.f, "the exponent shift below is log2(PSC) = 3");
  int tid = threadIdx.x; asm volatile("" : "+v"(tid));
  const int wid = __builtin_amdgcn_readfirstlane(tid >> 6), lane = tid & 63, r32 = lane & 31, hi = lane >> 5;
  char* K_lds = lds; char* V_lds = lds + 4 * SHM8;
  float* ws = (float*)(lds + 6 * SHM8) + wid * 64; float* al_l = ws + 32;
  f32x16 negm = {}; f32x16 o[4] = {}, o5 = {};
  char* Q_lds = lds + 6 * SHM8 + 2048;
  __syncthreads();
#pragma unroll
  for (int i = 0; i < 4; ++i) { const int idx = tid + 512 * i, row = idx >> 3, ch = idx & 7;
    *(i32x4*)(Q_lds + row * 128 + ((ch ^ ((row >> 1) & 7)) << 4)) = *(const GAS i32x4*)(Qb + (size_t)row * 1024 + 16 * ch); }
  const char* Qw = Q_lds + wid * 4096;
  const int skey = tid >> 3, skc = tid & 7, sd = tid >> 2, svc = tid & 3;
  const unsigned vst0 = (unsigned)(sd * 64 + ((((svc >> 1)) ^ ((sd >> 2) & 3)) << 4) + 8 * (svc & 1)), vst1 = (unsigned)(sd * 64 + (((2 + (svc >> 1)) ^ ((sd >> 2) & 3)) << 4) + 8 * (svc & 1));
  const unsigned kgo = (unsigned)(skey * 256 + 16 * (skc ^ ((skey >> 1) & 7)));
  const unsigned kdst = (unsigned)(uintptr_t)K_lds + (unsigned)wid * 1024u;
  const unsigned vgo = (unsigned)(sd * SEQ + 16 * svc);
  struct { i32x4 v; } sr_[SDEPTH];
#define SLOAD(i, k0) do { __builtin_amdgcn_global_load_lds((const GAS unsigned*)((const GAS char*)Kh + (size_t)(k0) * 256 + kgo), (LAS unsigned*)(kdst + ((((unsigned)(k0)) >> 6) & 3u) * (unsigned)SHM8), 16, 0, 0); \
    sr_[i].v = *(const GAS i32x4*)((const GAS char*)VTh + (k0) + vgo); } while (0)
#define SWRITE(b, i) do { \
    *(long long*)(V_lds + (b) * SHM8 + vst0) = ((long long)(unsigned)sr_[i].v[2] << 32) | (unsigned)sr_[i].v[0];   \
    *(long long*)(V_lds + (b) * SHM8 + vst1) = ((long long)(unsigned)sr_[i].v[3] << 32) | (unsigned)sr_[i].v[1]; } while (0)
#define SWAIT() do { if constexpr (SDEPTH == 2) asm volatile("s_waitcnt vmcnt(2)" ::: "memory"); else asm volatile("s_waitcnt vmcnt(0)" ::: "memory"); } while (0)
#define RESC(a) do { if (__any((a) < 1.f)) { if (hi == 0) al_l[r32] = (a); asm volatile("s_waitcnt lgkmcnt(0)" ::: "memory"); \
    for (int r = 0; r < 16; ++r) { const float f_ = al_l[crow(r, hi)]; o[0][r] *= f_; o[1][r] *= f_; o[2][r] *= f_; o[3][r] *= f_; o5[r] *= f_; } } } while (0)
  const int ks = (r32 >> 1) & 7, vs = (r32 >> 2) & 3;
  const int ka0 = r32 * 128 + (((2 * hi) ^ ks) << 4), ka1 = r32 * 128 + (((2 * hi + 1) ^ ks) << 4), ka2 = r32 * 128 + (((4 + 2 * hi) ^ ks) << 4), ka3 = r32 * 128 + (((5 + 2 * hi) ^ ks) << 4);
  const int va0 = r32 * 64 + (((2 * hi) ^ vs) << 4), va1 = r32 * 64 + (((2 * hi + 1) ^ vs) << 4);
#define QKT8(p0, p1, Kb) do { \
    { const i32x8 qa = cat8(*(const i32x4*)(Qw + ka0), *(const i32x4*)(Qw + ka1)); \
      mfma8qk(p0, negm, cat8(*(const i32x4*)((Kb) + ka0), *(const i32x4*)((Kb) + ka1)), qa); mfma8qk(p1, negm, cat8(*(const i32x4*)((Kb) + 4096 + ka0), *(const i32x4*)((Kb) + 4096 + ka1)), qa); } \
    { const i32x8 qb = cat8(*(const i32x4*)(Qw + ka2), *(const i32x4*)(Qw + ka3)); \
      mfma8qk(p0, p0, cat8(*(const i32x4*)((Kb) + ka2), *(const i32x4*)((Kb) + ka3)), qb); mfma8qk(p1, p1, cat8(*(const i32x4*)((Kb) + 4096 + ka2), *(const i32x4*)((Kb) + 4096 + ka3)), qb); } } while (0)
#define PV8(Vb, pk) do { _Pragma("unroll") for (int d0 = 0; d0 < 4; ++d0) mfma8(o[d0], pk, cat8(*(const i32x4*)((Vb) + d0 * 2048 + va0), *(const i32x4*)((Vb) + d0 * 2048 + va1))); \
    { int c38 = 0x38383838; asm volatile("" : "+v"(c38)); const i32x8 ones = {c38, c38, c38, c38, c38, c38, c38, c38}; mfma8(o5, pk, ones); } } while (0)
#define PSM8(p0, p1, alpha, FIRST) do { float pmax = p0[0]; for (int r = 1; r < 16; ++r) pmax = fmaxf(pmax, p0[r]); for (int r = 0; r < 16; ++r) pmax = fmaxf(pmax, p1[r]); \
    { auto rr = __builtin_amdgcn_permlane32_swap(__float_as_uint(pmax), __float_as_uint(pmax), false, false); pmax = fmaxf(__uint_as_float(rr[0]), __uint_as_float(rr[1])); } \
    alpha = 1.f; \
    if (FIRST || !__builtin_expect(__all(pmax <= XMAX), 1)) { const float dl = FIRST ? (pmax - 3.0f) : fmaxf(pmax - 3.0f, 0.f); alpha = __builtin_amdgcn_exp2f(-dl); \
      for (int r = 0; r < 16; ++r) { p0[r] -= dl; p1[r] -= dl; negm[r] -= dl; } } \
    for (int r = 0; r < 16; ++r) p0[r] = __builtin_amdgcn_exp2f(p0[r]); } while (0)
#define FSM8(p0, p1, pk) do { for (int r = 0; r < 16; ++r) p1[r] = __builtin_amdgcn_exp2f(p1[r]); \
    _Pragma("unroll") for (int w = 0; w < 4; ++w) { pk[w] = (int)pk4_fp8_nc(p0[4 * w], p0[4 * w + 1], p0[4 * w + 2], p0[4 * w + 3]); pk[4 + w] = (int)pk4_fp8_nc(p1[4 * w], p1[4 * w + 1], p1[4 * w + 2], p1[4 * w + 3]); } } while (0)
  f32x16 pA0, pA1, pB0, pB1; float alA, alB; i32x8 pk;
  constexpr int SE = 0, SO = SDEPTH - 1;
  __syncthreads();
  SLOAD(SE, 0); asm volatile("s_waitcnt vmcnt(0)" ::: "memory"); SWRITE(0, SE); __syncthreads();
  QKT8(pA0, pA1, K_lds); PSM8(pA0, pA1, alA, true);
  SLOAD(SO, KVBLK); if constexpr (SDEPTH == 2) { if (2 < NT) SLOAD(SE, 2 * KVBLK); }
  SWAIT(); SWRITE(1, SO); __syncthreads();
  for (int j = 1; j + 1 < NT; j += 2) {
    SBAR(); QKT8(pB0, pB1, K_lds + (j & 3) * SHM8);
    FSM8(pA0, pA1, pk); SBAR();
    SLOAD(SO, (j + SDEPTH) * KVBLK); SBAR();
    PV8(V_lds, pk); PSM8(pB0, pB1, alB, false);
    __syncthreads(); SWAIT(); SWRITE(0, SE);
    RESC(alB); __syncthreads();
    SBAR(); QKT8(pA0, pA1, K_lds + ((j + 1) & 3) * SHM8);
    FSM8(pB0, pB1, pk); SBAR();
    if (SDEPTH == 1 || j + 3 < NT) SLOAD(SE, (j + 1 + SDEPTH) * KVBLK); SBAR();
    PV8(V_lds + SHM8, pk); PSM8(pA0, pA1, alA, false);
    __syncthreads(); SWAIT(); SWRITE(1, SO);
    RESC(alA); __syncthreads();
  }
  SBAR(); QKT8(pB0, pB1, K_lds + ((NT - 1) & 3) * SHM8);
  FSM8(pA0, pA1, pk); SBAR();
  PV8(V_lds, pk); PSM8(pB0, pB1, alB, false);
  __syncthreads(); RESC(alB);
  FSM8(pB0, pB1, pk); SBAR();
  PV8(V_lds + SHM8, pk);
  unsigned char* Ow = Ob + (long)(wid * QBLK) * LDO + 4 * r32;
#pragma unroll
  for (int r = 0; r < 16; ++r) { const int orow = crow(r, hi); const float rl = __builtin_amdgcn_rcpf(o5[r] * QS);
    const float sr = rl * OS; *(unsigned*)(Ow + (long)orow * LDO) = pk4_fp8(o[0][r] * sr, o[1][r] * sr, o[2][r] * sr, o[3][r] * sr); }
#undef SLOAD
#undef SWRITE
#undef SWAIT
#undef RESC
#undef QKT8
#undef PV8
#undef PSM8
#undef FSM8
}
#undef KSWZ
#undef SBAR
}

#define XB_TMO      128
#define XB_XCNT(j)  (256  + 64 * (j))
#define XB_XSUB(j)  (1280 + 64 * (j))
#define XB_XGEN(j)  (2304 + 64 * (j))
#define XB_TOP      3328
#define XB_TOPGEN   3392
#define XCD_BAR_WORDS 3456
#define XB_SPIN_CAP (1u << 18)
__device__ __forceinline__ unsigned xb_ld(unsigned* p)              { return __hip_atomic_load(p, __ATOMIC_RELAXED, __HIP_MEMORY_SCOPE_AGENT); }
__device__ __forceinline__ unsigned xb_add(unsigned* p, unsigned v) { return __hip_atomic_fetch_add(p, v, __ATOMIC_RELAXED, __HIP_MEMORY_SCOPE_AGENT); }
__device__ __forceinline__ unsigned xb_xcc_id() { return (unsigned)__builtin_amdgcn_s_getreg((3 << 11) | 20) & 0xFu; }
#define XB_SPIN(cond, bar) do { unsigned _sp = 0; while (cond) { __builtin_amdgcn_s_sleep(1); \
    if ((++_sp & 255u) == 0u) { if (xb_ld(&(bar)[XB_TMO])) break; if (_sp > XB_SPIN_CAP) { atomicAdd(&(bar)[XB_TMO], 1u); break; } } } } while (0)
struct XcdBarrier { unsigned* bar; unsigned x; volatile LAS unsigned* st; };
__device__ __forceinline__ XcdBarrier xcd_barrier_post(unsigned* bar, volatile LAS unsigned* st) {
    XcdBarrier b; b.bar = bar; b.x = xb_xcc_id(); b.st = st;
    if (threadIdx.x == 0) (void)xb_add(&bar[XB_XCNT(b.x)], 1u);
    return b;
}
__device__ __forceinline__ void xcd_barrier_complete(unsigned* bar, unsigned x, unsigned& nloc, unsigned& nx) {
    const unsigned G = gridDim.x * gridDim.y * gridDim.z;
    unsigned sum, cnt, mine, sp = 0u;
    for (;;) {
        sum = 0u; cnt = 0u; mine = 0u;
#pragma unroll
        for (unsigned j = 0; j < 16; ++j) { const unsigned c = xb_ld(&bar[XB_XCNT(j)]); sum += c; cnt += (c > 0u) ? 1u : 0u; mine = (j == x) ? c : mine; }
        if (sum == G) break;
        __builtin_amdgcn_s_sleep(1);
        if ((++sp & 255u) == 0u) { if (xb_ld(&bar[XB_TMO])) break; if (sp > XB_SPIN_CAP) { atomicAdd(&bar[XB_TMO], 1u); break; } }
    }
    nloc = mine > 0u ? mine : 1u; nx = cnt > 0u ? cnt : 1u;
}
__device__ __forceinline__ void xcd_barrier(const XcdBarrier& b) {
    asm volatile("s_waitcnt vmcnt(0)" ::: "memory");
    __syncthreads();
    if (threadIdx.x == 0) {
        unsigned* bar = b.bar;
        __builtin_amdgcn_s_waitcnt(0);
        unsigned nloc = b.st[0], nx = b.st[1];
        if (nloc == 0u) { xcd_barrier_complete(bar, b.x, nloc, nx); b.st[0] = nloc; b.st[1] = nx; }
        const unsigned old = xb_add(&bar[XB_XSUB(b.x)], 1u);
        const unsigned gen = old / nloc;
        if (old + 1u == (gen + 1u) * nloc) {
            __builtin_amdgcn_fence(__ATOMIC_RELEASE, "agent");
            asm volatile("s_waitcnt vmcnt(0)" ::: "memory");
            const unsigned og = xb_add(&bar[XB_TOP], 1u);
            const unsigned tg = og / nx;
            if (og + 1u == (tg + 1u) * nx) xb_add(&bar[XB_TOPGEN], 1u);
            else XB_SPIN(xb_ld(&bar[XB_TOPGEN]) == tg, bar);
            __builtin_amdgcn_fence(__ATOMIC_ACQUIRE, "agent");
            xb_add(&bar[XB_XGEN(b.x)], 1u);
            asm volatile("s_waitcnt vmcnt(0)" ::: "memory");
        } else {
            XB_SPIN(xb_ld(&bar[XB_XGEN(b.x)]) == gen, bar);
            __builtin_amdgcn_fence(__ATOMIC_ACQUIRE, "agent");
            asm volatile("s_waitcnt vmcnt(0)" ::: "memory");
        }
    }
    __syncthreads();
}

__device__ __forceinline__ unsigned f2bf(float f) { unsigned u = __builtin_bit_cast(unsigned, f); return (u + 0x7fffu + ((u >> 16) & 1u)) >> 16; }
__device__ __forceinline__ unsigned pk2(float lo, float hi) { return f2bf(lo) | (f2bf(hi) << 16); }
__device__ __forceinline__ void transpose_item(const float* W, int K, int N, bf16* WT, LAS float* scr, int item, int lane) {
    const int nblk = N / 32, kb = item / nblk, nb = item % nblk, k0 = 64 * kb, n0 = 32 * nb;
    const int kr = lane >> 3, c4 = (lane & 7) * 4;
    const float* src = W + (size_t)(k0 + kr) * N + n0 + c4;
    f32x4 v[8];
#pragma unroll
    for (int i = 0; i < 8; ++i) v[i] = __builtin_nontemporal_load((const f32x4*)(src + (size_t)(8 * i) * N));
#pragma unroll
    for (int i = 0; i < 8; ++i) { LAS float* d = scr + (8 * i + kr) * 33 + c4; d[0] = v[i].x; d[1] = v[i].y; d[2] = v[i].z; d[3] = v[i].w; }
    LDS_WAIT(); asm volatile("" ::: "memory");
    const int c = lane & 7;
#pragma unroll
    for (int j = 0; j < 4; ++j) { const int n = (lane >> 3) + 8 * j; const LAS float* s = scr + (8 * c) * 33 + n;
        v4u o; o.x = pk2(s[0 * 33], s[1 * 33]); o.y = pk2(s[2 * 33], s[3 * 33]); o.z = pk2(s[4 * 33], s[5 * 33]); o.w = pk2(s[6 * 33], s[7 * 33]);
        *(v4u*)(WT + (size_t)(n0 + n) * K + k0 + 8 * c) = o; }
    LDS_WAIT(); asm volatile("" ::: "memory");
}
template <bool PERMK = false>
__device__ __forceinline__ void transpose_item8(const float* W, int K, int N, unsigned char* WT, LAS float* scr, int item, int lane, float sc) {
    const int nblk = N / 32, kb = item / nblk, nb = item % nblk, k0 = 128 * kb, n0 = 32 * nb;
    const int kr = lane >> 3, c4 = (lane & 7) * 4;
    const float* src = W + (size_t)(k0 + kr) * N + n0 + c4;
    f32x4 v[16];
#pragma unroll
    for (int i = 0; i < 16; ++i) v[i] = __builtin_nontemporal_load((const f32x4*)(src + (size_t)(8 * i) * N));
#pragma unroll
    for (int i = 0; i < 16; ++i) { LAS float* d = scr + (8 * i + kr) * 33 + c4; d[0] = v[i].x; d[1] = v[i].y; d[2] = v[i].z; d[3] = v[i].w; }
    LDS_WAIT(); asm volatile("" ::: "memory");
    const int c = lane & 7;
#pragma unroll
    for (int j = 0; j < 4; ++j) { const int n = (lane >> 3) + 8 * j;
        if constexpr (PERMK) {
            const LAS float* s = scr + (4 * c) * 33 + n; v4u o;
#define PK_(q) pk4_fp8(s[(0 * 32 + (q)) * 33] * sc, s[(1 * 32 + (q)) * 33] * sc, s[(2 * 32 + (q)) * 33] * sc, s[(3 * 32 + (q)) * 33] * sc)
            o.x = PK_(0); o.y = PK_(1); o.z = PK_(2); o.w = PK_(3);
#undef PK_
            __builtin_nontemporal_store(o, (v4u*)(WT + (size_t)(n0 + n) * K + k0 + 16 * c)); continue; }
        const LAS float* s = scr + (16 * c) * 33 + n;
        v4u o; o.x = pk4_fp8(s[0 * 33] * sc, s[1 * 33] * sc, s[2 * 33] * sc, s[3 * 33] * sc); o.y = pk4_fp8(s[4 * 33] * sc, s[5 * 33] * sc, s[6 * 33] * sc, s[7 * 33] * sc);
        o.z = pk4_fp8(s[8 * 33] * sc, s[9 * 33] * sc, s[10 * 33] * sc, s[11 * 33] * sc); o.w = pk4_fp8(s[12 * 33] * sc, s[13 * 33] * sc, s[14 * 33] * sc, s[15 * 33] * sc);
        __builtin_nontemporal_store(o, (v4u*)(WT + (size_t)(n0 + n) * K + k0 + 16 * c)); }
    LDS_WAIT(); asm volatile("" ::: "memory");
}
__device__ __forceinline__ void rms_row_to_bf16(const float* xrow, const float* g, unsigned char* orow, int lane) {
    const f32x4* xr = (const f32x4*)xrow + lane; const f32x4* gr = (const f32x4*)g + lane;
    f32x4 v[8]; float s = 0.f;
#pragma unroll
    for (int j = 0; j < 8; ++j) { v[j] = __builtin_nontemporal_load(xr + 64 * j); s += (v[j].x * v[j].x + v[j].y * v[j].y) + (v[j].z * v[j].z + v[j].w * v[j].w); }
    const float rstd = 1.0f / sqrtf(wave_sum(s) * (1.f / DM) + EPS);
    unsigned* o8 = (unsigned*)orow + lane; const float rs = rstd * HS;
#pragma unroll
    for (int j = 0; j < 8; ++j) { const f32x4 gg = gr[64 * j]; o8[64 * j] = pk4_fp8(v[j].x * rs * gg.x, v[j].y * rs * gg.y, v[j].z * rs * gg.z, v[j].w * rs * gg.w); }
}

template <int R>
__device__ __forceinline__ void rms_rows_to_bf16(const float* x0, size_t rstride, const float* g, unsigned char* o0, size_t ostride, int lane) {
    f32x4 v[R][8]; float s[R];
#pragma unroll
    for (int r = 0; r < R; ++r) { const f32x4* xr = (const f32x4*)(x0 + r * rstride) + lane; s[r] = 0.f;
#pragma unroll
        for (int j = 0; j < 8; ++j) v[r][j] = __builtin_nontemporal_load(xr + 64 * j); }
    const f32x4* gr = (const f32x4*)g + lane;
#pragma unroll
    for (int r = 0; r < R; ++r) {
#pragma unroll
        for (int j = 0; j < 8; ++j) s[r] += (v[r][j].x * v[r][j].x + v[r][j].y * v[r][j].y) + (v[r][j].z * v[r][j].z + v[r][j].w * v[r][j].w);
        const float rstd = 1.0f / sqrtf(wave_sum(s[r]) * (1.f / DM) + EPS);
        unsigned* o8 = (unsigned*)(o0 + r * ostride) + lane; const float rs = rstd * HS;
#pragma unroll
        for (int j = 0; j < 8; ++j) { const f32x4 gg = gr[64 * j]; o8[64 * j] = pk4_fp8(v[r][j].x * rs * gg.x, v[r][j].y * rs * gg.y, v[r][j].z * rs * gg.z, v[r][j].w * rs * gg.w); } }
}

constexpr int I_GU = (DM / 128) * (DFF / 32), I_DN = (DFF / 128) * (DM / 32), NFFN_ITEMS = NE * (2 * I_GU + I_DN), NSLOT = 3;
constexpr int NGU_ITEMS = 2 * NE * I_GU, GU_SHARE = (NGU_ITEMS + NSLOT - 1) / NSLOT;
__device__ __attribute__((noinline)) void ffn_conv(const float* wg, const float* wu, const float* wd, unsigned char* WG_T, unsigned char* WU_T, unsigned char* WD_T, LAS unsigned char* L, int r0, int q, int wgi, int nwg) {
    __syncthreads();
    int tid = threadIdx.x; asm volatile("" : "+v"(tid));
    const int lane = tid & 63, wave = __builtin_amdgcn_readfirstlane(tid >> 6);
    LAS float* scr = (LAS float*)(L + wave * 16896);
    const int nw = nwg * NWAVES;
    for (int li = wgi * NWAVES + wave; li < q; li += nw) {
        int r = r0 + li;
        if (r < NE * I_GU) { const int e = r / I_GU; transpose_item8(wg + (size_t)e * DM * DFF, DM, DFF, WG_T + (size_t)e * DFF * DM, scr, r % I_GU, lane, WS); continue; } r -= NE * I_GU;
        if (r < NE * I_GU) { const int e = r / I_GU; transpose_item8(wu + (size_t)e * DM * DFF, DM, DFF, WU_T + (size_t)e * DFF * DM, scr, r % I_GU, lane, WS); continue; } r -= NE * I_GU;
        { const int e = r / I_DN; transpose_item8(wd + (size_t)e * DFF * DM, DFF, DM, WD_T + (size_t)e * DM * DFF, scr, r % I_DN, lane, WDS); }
    }
    __syncthreads();
}

struct Args { const float* in[13]; float* out; unsigned char* ws; int ph_lo, ph_hi; };

__global__ void __launch_bounds__(NWAVES * 64, 2) hymba_fwd(Args args) {
    extern __shared__ __attribute__((aligned(16))) unsigned char lds[];
    LAS unsigned char* L = (LAS unsigned char*)lds;
    volatile LAS unsigned* MISC = (volatile LAS unsigned*)(L + MISC_OFF);
    const int G = gridDim.x; const int bx = blockIdx.x; const int vcu = (G % 8 == 0) ? (bx % 8) * (G / 8) + bx / 8 : bx;
    const int NGW = G * NWAVES;
#define PH_IDS int tid = threadIdx.x; asm volatile("" : "+v"(tid)); const int lane = tid & 63, wave = __builtin_amdgcn_readfirstlane(tid >> 6), gw = vcu * NWAVES + wave; (void)lane; (void)gw;
    unsigned char* ws = args.ws;
    unsigned* ctl = (unsigned*)(ws + WS_CTL);
    for (int u = threadIdx.x; u < (LDS_BYTES - LDSCTL_OFF) / 4; u += NWAVES * 64) ((LAS unsigned*)(L + LDSCTL_OFF))[u] = 0u;
    __syncthreads();
    XcdBarrier bar; bar.bar = ctl + CW_BAR; bar.x = 0; bar.st = nullptr;
    if (!MK_SPLIT) bar = xcd_barrier_post(ctl + CW_BAR, MISC + 8);
#define GRID_BAR() do { if (!MK_SPLIT) xcd_barrier(bar); } while (0)
    const int lo = args.ph_lo, hi = args.ph_hi;
#ifdef PH_ONLY
#define IN(k) ((k) == PH_ONLY && lo <= (k) && (k) < hi)
#else
#define IN(k) (lo <= (k) && (k) < hi)
#endif
#define BOTH(k) (IN(k) && IN((k) + 1))

    const float* x = args.in[0];
    unsigned char* WIN_T = ws + WS_WIN; unsigned char* WOUT_T = ws + WS_WOUT; unsigned char* WG_T = ws + WS_WG; unsigned char* WU_T = ws + WS_WU; unsigned char* WD_T = ws + WS_WD;
    unsigned char* HN = ws + WS_HN; bf16* PROJ = (bf16*)(ws + WS_PROJ); unsigned char* ATT = ws + WS_ATT; float* RSTD = (float*)(ws + WS_RSTD); float* RS = (float*)(ws + WS_RS);
    unsigned char* Q8 = ws + WS_Q8; unsigned char* K8 = ws + WS_K8; unsigned char* VT8 = ws + WS_VT8;
    unsigned char* XG = ws + WS_XG; unsigned char* H8 = ws + WS_H8; unsigned char* ACT = ws + WS_ACT; bf16* EO = (bf16*)(ws + WS_EO);
    bf16* X1 = (bf16*)(ws + WS_PROJ);
    float* AFF = (float*)(ws + WS_AFF); int* IDX = (int*)(ws + WS_IDX); float* GATE = (float*)(ws + WS_GATE); int* SLOT = (int*)(ws + WS_SLOT);

    if (IN(0)) REP(0) {
        PH_IDS
        LAS float* scr = (LAS float*)(L + wave * 16896);
        constexpr int I_IN = (DM / 128) * (DIN / 32), I_OUT = (DM / 128) * (DM / 32);
        for (int it = gw; it < I_IN + I_OUT; it += NGW) {
            if (it < I_IN) transpose_item8<false>(args.in[2], DM, DIN, WIN_T, scr, it, lane, WIS);
            else transpose_item8<true>(args.in[6], DM, DM, WOUT_T, scr, it - I_IN, lane, WIS);
        }
        { int m = gw;
          for (; m + 3 * NGW < T; m += 4 * NGW) rms_rows_to_bf16<4>(x + (size_t)m * DM, (size_t)NGW * DM, args.in[1], HN + (size_t)m * DM, (size_t)NGW * DM, lane);
          for (; m < T; m += NGW) rms_row_to_bf16(x + (size_t)m * DM, args.in[1], HN + (size_t)m * DM, lane); }
        if (BOTH(0)) GRID_BAR();
    }

    if (IN(1)) REP(1) {
        pg8::Gemm g{(const pg8::bf16_t*)HN, (const pg8::bf16_t*)WIN_T, DM / 2, T / 256, DIN / 256, (size_t)32 * DM, (size_t)256 * DM, 0, nullptr, nullptr};
        pg8::StaticOrder S; S.init(T / 256, DIN / 256, G, bx);
        LAS float* rtab = (LAS float*)(L + RING_BYTES + 4096);
        for (int idx = threadIdx.x; idx < 64 * 32; idx += NWAVES * 64) { float a = (float)(idx >> 5) * __builtin_amdgcn_exp2f(-(float)(idx & 31) * (13.287712379549449f / 32.0f)) * 0.15915494309189535f; a -= floorf(a);
            rtab[2 * idx] = __builtin_amdgcn_cosf(a); rtab[2 * idx + 1] = __builtin_amdgcn_sinf(a); }
        __syncthreads();
        pg8::EpiProj E{PROJ, DIN, args.in[4], args.in[5], (LAS float*)(L + RING_BYTES), rtab, 1.0f / (HS * WIS), Q8, K8, VT8};
        pg8::gemm_phase<pg8::EpiProj, pg8::StaticOrder, true, true, true>(L, g, S, E);
        if (BOTH(1)) GRID_BAR();
    }


    if (IN(3)) REP(3) {
        const int slot = vcu % NSLOT; int seq = 0; bool conv_done = false;
#define FFN_CONV() do { const int r0_ = slot * GU_SHARE, q_ = (NGU_ITEMS - r0_) < GU_SHARE ? (NGU_ITEMS - r0_) : GU_SHARE; \
            ffn_conv(args.in[9], args.in[10], args.in[11], WG_T, WU_T, WD_T, L, r0_, q_, vcu / NSLOT, (G - slot + NSLOT - 1) / NSLOT); conv_done = true; } while (0)
        for (int U = vcu; U < 512; U += G, ++seq) {
            if (slot == seq && !conv_done) FFN_CONV();
            const int combo = (U >> 5) & 7, j = (U >> 8) * 32 + (U & 31);
            const int b = combo >> 1, kvh = combo & 1, h = kvh * 4 + (j >> 4), qb = j & 15, q0 = qb * 256;
            const size_t rowb = (size_t)b * SEQ;
            att::attn_body8<ATT_SD_B>(Q8 + (rowb + q0) * 1024 + h * HD, K8 + rowb * 256 + kvh * HD, VT8 + (size_t)(b * 2 + kvh) * HD * SEQ,
                                  ATT + (rowb + q0) * DM + 1024 + h * HD, SEQ / 64, (char*)lds);
        }
        if (slot <= 2 && !conv_done) FFN_CONV();
        for (int U = vcu; U < 512; U += G) {
            const int combo = (U >> 5) & 7, j = (U >> 8) * 32 + (U & 31);
            const int b = combo >> 1, kvh = combo & 1, h = kvh * 4 + (j >> 4), qb = j & 15, q0 = qb * 256;
            const size_t rowb = (size_t)b * SEQ;
            const int klo = q0 >= 128 ? q0 - 128 : 0, khi = (q0 + 384 <= SEQ) ? q0 + 384 : SEQ;
            att::attn_body<true, ATT_SD_A>(PROJ + (rowb + q0) * DIN + COL_QA + h * HD, PROJ + (rowb + klo) * DIN + COL_KA + kvh * HD,
                                 ATT + (rowb + q0) * DM + h * HD, (khi - klo) / 64, (char*)lds, q0 - klo, __builtin_amdgcn_exp2f(-(float)(h + 1)), args.in[3][h]);
        }
        if (!conv_done) FFN_CONV();
#undef FFN_CONV
        if (BOTH(3)) GRID_BAR();
    }

    if (IN(4)) REP(4) {
        pg8::Gemm g{(const pg8::bf16_t*)ATT, (const pg8::bf16_t*)WOUT_T, DM / 2, T / 256, DM / 256, (size_t)128 * DM, (size_t)256 * DM, 0, nullptr, nullptr};
        pg8::StaticOrder S; S.init(T / 256, DM / 256, G, bx);
        pg8::EpiX1 E{X1, x, DM, 1.0f / (OS * WIS)};
        pg8::gemm_phase<pg8::EpiX1, pg8::StaticOrder, true, true, true>(L, g, S, E);
        if (BOTH(4)) GRID_BAR();
    }

    if (IN(5)) REP(5) {
        PH_IDS
        constexpr int WST = DM + 4;
        LAS float* wT = (LAS float*)L; LAS float* gL = (LAS float*)(L + NE * WST * 4); LAS float* comb = (LAS float*)(L + NE * WST * 4 + DM * 4);
        static_assert(NE * WST * 4 + DM * 4 + 4 * 64 * 5 * 4 <= LDSCTL_OFF, "P5 LDS map");
        for (int idx = tid; idx < NE * DM; idx += NWAVES * 64) { const int e = idx & 15, d = idx >> 4; wT[e * WST + d] = args.in[8][idx] * args.in[7][d]; }
        for (int d = tid; d < DM; d += NWAVES * 64) gL[d] = args.in[7][d];
        __syncthreads();
        const int j = lane & 15, kq = lane >> 4, gi = wave & 3, kh = wave >> 2;
        for (int base = vcu * 4; base < T / 16; base += G * 4) {
            asm volatile("" ::: "memory");
            const int t0 = (base + gi) * 16;
            const size_t rowoff = (size_t)(t0 + j) * DM + kh * 1024 + 8 * kq;
            const bf16* mp = X1 + rowoff; unsigned char* hp = H8 + rowoff;
            const LAS float* wp = wT + j * WST + kh * 1024 + 8 * kq; const LAS float* gp = gL + kh * 1024 + 8 * kq;
            f32x4 acc = {0.f, 0.f, 0.f, 0.f}; float ss = 0.f;
            v4u mm[2][4];
#define P5_LOAD(bf, bt) do { _Pragma("unroll") for (int u = 0; u < 4; ++u) { const int m = (bt) * 4 + u; mm[bf][u] = __builtin_nontemporal_load((const v4u*)(mp + 32 * m)); } } while (0)
#define P5_COMP(bf, bt) do { _Pragma("unroll") for (int u = 0; u < 4; ++u) { const int m = (bt) * 4 + u; \
                const f32x4 wa = *(const LAS f32x4*)(wp + 32 * m), wb = *(const LAS f32x4*)(wp + 32 * m + 4), ga = *(const LAS f32x4*)(gp + 32 * m), gb = *(const LAS f32x4*)(gp + 32 * m + 4); \
                const v4u q = mm[bf][u]; const f32x4 a = {bf_lo(q.x), bf_hi(q.x), bf_lo(q.y), bf_hi(q.y)}, b = {bf_lo(q.z), bf_hi(q.z), bf_lo(q.w), bf_hi(q.w)}; \
                acc = __builtin_amdgcn_mfma_f32_16x16x4f32(wa.x, a.x, acc, 0, 0, 0); acc = __builtin_amdgcn_mfma_f32_16x16x4f32(wa.y, a.y, acc, 0, 0, 0); \
                acc = __builtin_amdgcn_mfma_f32_16x16x4f32(wa.z, a.z, acc, 0, 0, 0); acc = __builtin_amdgcn_mfma_f32_16x16x4f32(wa.w, a.w, acc, 0, 0, 0); \
                acc = __builtin_amdgcn_mfma_f32_16x16x4f32(wb.x, b.x, acc, 0, 0, 0); acc = __builtin_amdgcn_mfma_f32_16x16x4f32(wb.y, b.y, acc, 0, 0, 0); \
                acc = __builtin_amdgcn_mfma_f32_16x16x4f32(wb.z, b.z, acc, 0, 0, 0); acc = __builtin_amdgcn_mfma_f32_16x16x4f32(wb.w, b.w, acc, 0, 0, 0); \
                ss += (a.x * a.x + a.y * a.y) + (a.z * a.z + a.w * a.w) + (b.x * b.x + b.y * b.y) + (b.z * b.z + b.w * b.w); \
                v2u o; o.x = pk4_fp8(a.x * ga.x * XS, a.y * ga.y * XS, a.z * ga.z * XS, a.w * ga.w * XS); o.y = pk4_fp8(b.x * gb.x * XS, b.y * gb.y * XS, b.z * gb.z * XS, b.w * gb.w * XS); \
                *(v2u*)(hp + 32 * m) = o; } } while (0)
            P5_LOAD(0, 0);
#pragma unroll
            for (int bt = 0; bt < 8; bt += 2) {
                P5_LOAD(1, bt + 1);
                P5_COMP(0, bt);
                if (bt + 2 < 8) P5_LOAD(0, bt + 2);
                P5_COMP(1, bt + 1);
            }
#undef P5_LOAD
#undef P5_COMP
            LAS float* cb = comb + (gi * 64 + lane) * 5;
            if (kh == 1) { cb[0] = acc[0]; cb[1] = acc[1]; cb[2] = acc[2]; cb[3] = acc[3]; cb[4] = ss; }
            __syncthreads();
            if (kh == 0) {
                acc[0] += cb[0]; acc[1] += cb[1]; acc[2] += cb[2]; acc[3] += cb[3]; ss += cb[4];
                ss += __shfl_xor(ss, 16); ss += __shfl_xor(ss, 32);
                const float rstd = 1.0f / sqrtf(ss * (1.f / DM) + EPS);
                float l0 = acc[0] * rstd, l1 = acc[1] * rstd, l2 = acc[2] * rstd, l3 = acc[3] * rstd;
                float mx = fmaxf(fmaxf(l0, l1), fmaxf(l2, l3)); mx = fmaxf(mx, __shfl_xor(mx, 16)); mx = fmaxf(mx, __shfl_xor(mx, 32));
                l0 = __expf(l0 - mx); l1 = __expf(l1 - mx); l2 = __expf(l2 - mx); l3 = __expf(l3 - mx);
                float den = (l0 + l1) + (l2 + l3); den += __shfl_xor(den, 16); den += __shfl_xor(den, 32);
                const float rden = 1.0f / den;
                float* ap = AFF + ((size_t)(t0 >> 12) * NE + 4 * kq) * SEQ + (t0 & (SEQ - 1)) + j;
                ap[0] = l0 * rden; ap[SEQ] = l1 * rden; ap[2 * SEQ] = l2 * rden; ap[3 * SEQ] = l3 * rden;
                if (kq == 0) RSTD[t0 + j] = rstd;
            }
            __syncthreads();
        }
        if (BOTH(5)) GRID_BAR();
    }

    if (IN(6)) REP(6) {
        PH_IDS
        LAS unsigned* red = (LAS unsigned*)L;
        for (int be = vcu; be < BATCH * NE; be += G) {
            const int b = be / NE, e = be % NE;
            const float* a = AFF + (size_t)be * SEQ + tid * 8;
            const f32x4 a0 = *(const f32x4*)a, a1 = *(const f32x4*)(a + 4);
            float av[8] = {a0.x, a0.y, a0.z, a0.w, a1.x, a1.y, a1.z, a1.w};
            unsigned key[8];
#pragma unroll
            for (int i = 0; i < 8; ++i) key[i] = __float_as_uint(av[i]);
            unsigned prefix = 0u;
            for (int bit = 30; bit >= 0; --bit) {
                const unsigned cand = prefix | (1u << bit);
                unsigned c = 0u;
#pragma unroll
                for (int i = 0; i < 8; ++i) c += (unsigned)__builtin_popcountll(__ballot(key[i] >= cand));
                LAS unsigned* slot = red + (bit & 1) * 8;
                if (lane == 0) slot[wave] = c;
                __syncthreads();
                unsigned tot = 0u;
#pragma unroll
                for (int w = 0; w < 8; ++w) tot += slot[w];
                if (tot >= (unsigned)CAP) prefix = cand;
            }
            __syncthreads();
            unsigned cgt = 0u, ceq = 0u;
#pragma unroll
            for (int i = 0; i < 8; ++i) { cgt += (key[i] > prefix) ? 1u : 0u; ceq += (key[i] == prefix) ? 1u : 0u; }
            unsigned pk = cgt | (ceq << 16), incl = pk;
#pragma unroll
            for (int o = 1; o < 64; o <<= 1) { const unsigned n = __shfl_up(incl, o); if (lane >= o) incl += n; }
            LAS unsigned* wtot = red + 64;
            if (lane == 63) wtot[wave] = incl;
            __syncthreads();
            unsigned woff = 0u, total = 0u;
#pragma unroll
            for (int w = 0; w < 8; ++w) { const unsigned v = wtot[w]; if (w < wave) woff += v; total += v; }
            const unsigned excl = woff + incl - pk;
            const unsigned need_eq = (unsigned)CAP - (total & 0xffffu);
            unsigned gt_before = excl & 0xffffu, eq_before = excl >> 16;
            const int mbase = (e * BATCH + b) * CAP;
#pragma unroll
            for (int i = 0; i < 8; ++i) {
                const int tok = tid * 8 + i;
                const bool isgt = key[i] > prefix, iseq = key[i] == prefix;
                const bool sel = isgt || (iseq && eq_before < need_eq);
                const unsigned slot = gt_before + (eq_before < need_eq ? eq_before : need_eq);
                if (sel) { IDX[mbase + slot] = tok; GATE[mbase + slot] = av[i]; RS[mbase + slot] = RSTD[(size_t)b * SEQ + tok]; }
                SLOT[((size_t)b * SEQ + tok) * NE + e] = sel ? (int)slot : -1;
                gt_before += isgt ? 1u : 0u; eq_before += iseq ? 1u : 0u;
            }
            __syncthreads();
        }
        if (BOTH(6)) GRID_BAR();
    }


    if (IN(8)) REP(8) {
        pg8::Gemm g{(const bf16*)H8, (const bf16*)WG_T, DM / 2, MS / 256, DFF / 128, (size_t)(WS_WU - WS_WG), (size_t)128 * DM, (size_t)DFF * DM, IDX, (LAS int*)(L + RING_BYTES + 20480)};
        pg8::StaticOrder S; S.init(MS / 256, DFF / 128, G, bx);
        pg8::EpiSwiGlu8 E{ACT, DFF, 1.0f / (XS * WS), AS, RS};
        const int nmine = (MS / 256 * (DFF / 128) - bx + G - 1) / G, split = nmine > 0 ? vcu % nmine : 0;
        for (int part = 0; part < 2; ++part) {
            S.i0 = part ? split : 0; S.ni = part ? (1 << 30) : split;
            pg8::gemm_phase<pg8::EpiSwiGlu8, pg8::StaticOrder, true, true, true, true>(L, g, S, E);
            if (part == 0) ffn_conv(args.in[9], args.in[10], args.in[11], WG_T, WU_T, WD_T, L, NGU_ITEMS, NFFN_ITEMS - NGU_ITEMS, vcu, G);
        }
        if (BOTH(8)) GRID_BAR();
    }

    if (IN(9)) REP(9) {
        pg8::Gemm g{(const bf16*)ACT, (const bf16*)WD_T, DFF / 2, MS / 256, DM / 256, (size_t)128 * DFF, (size_t)256 * DFF, (size_t)DM * DFF, nullptr, nullptr};
        pg8::StaticOrder S; S.init(MS / 256, DM / 256, G, bx);
        pg8::EpiBf16 E{EO, DM, 1.0f / (AS * WDS)};
        pg8::gemm_phase<pg8::EpiBf16, pg8::StaticOrder, true, true, true>(L, g, S, E);
        if (BOTH(9)) GRID_BAR();
    }

    if (IN(10)) REP(10) {
        PH_IDS
        const unsigned bad = __hip_atomic_load(ctl + CW_BAR + XB_TMO, RLX_AGENT);
        f32x4 gg[8];
#pragma unroll
        for (int j = 0; j < 8; ++j) gg[j] = ((const f32x4*)args.in[12])[lane + 64 * j];
        for (int t = gw; t < T; t += NGW) {
            const v2u* mr = (const v2u*)(X1 + (size_t)t * DM) + lane;
            f32x4 v[8];
#pragma unroll
            for (int j = 0; j < 8; ++j) { const v2u w = __builtin_nontemporal_load(mr + 64 * j); v[j].x = bf_lo(w.x); v[j].y = bf_hi(w.x); v[j].z = bf_lo(w.y); v[j].w = bf_hi(w.y); }
            const int myslot = SLOT[(size_t)t * NE + (lane & 15)];
            const int b = t >> 12;
            for (int e = 0; e < NE; ++e) {
                const int sl = __builtin_amdgcn_readlane(myslot, e);
                if (sl >= 0) {
                    const int m = (e * BATCH + b) * CAP + sl; const float gt = GATE[m];
                    const v2u* er = (const v2u*)(EO + (size_t)m * DM) + lane;
#pragma unroll
                    for (int j = 0; j < 8; ++j) { const v2u w = __builtin_nontemporal_load(er + 64 * j); v[j].x += gt * bf_lo(w.x); v[j].y += gt * bf_hi(w.x); v[j].z += gt * bf_lo(w.y); v[j].w += gt * bf_hi(w.y); }
                }
            }
            float s = 0.f;
#pragma unroll
            for (int j = 0; j < 8; ++j) s += (v[j].x * v[j].x + v[j].y * v[j].y) + (v[j].z * v[j].z + v[j].w * v[j].w);
            const float rstd = bad ? __builtin_nanf("") : 1.0f / sqrtf(wave_sum(s) * (1.f / DM) + EPS);
            f32x4* orow = (f32x4*)(args.out + (size_t)t * DM) + lane;
#pragma unroll
            for (int j = 0; j < 8; ++j) __builtin_nontemporal_store(v[j] * rstd * gg[j], orow + 64 * j);
        }
    }
#undef PH_IDS
#undef IN
#undef BOTH
#undef GRID_BAR
}

extern "C" void kernel_launch(void* const* d_in, const int* in_sizes, int n_in, void* d_out, int out_size, void* d_ws, size_t ws_size, hipStream_t stream) {
    static int grid = 0;
    if (grid == 0) {
        if (n_in != 13 || in_sizes[0] != T * DM || out_size != T * DM || ws_size < WS_END) {
            fprintf(stderr, "kernel_launch: shape mismatch: n_in %d in0 %d out %d ws %zu (need >= %zu)\n", n_in, n_in > 0 ? in_sizes[0] : -1, out_size, ws_size, (size_t)WS_END); grid = -1; return; }
        int dev = 0, cus = 0;
        if (hipGetDevice(&dev) != hipSuccess || hipDeviceGetAttribute(&cus, hipDeviceAttributeMultiprocessorCount, dev) != hipSuccess) { grid = -1; return; }
        if (hipFuncSetAttribute((const void*)hymba_fwd, hipFuncAttributeMaxDynamicSharedMemorySize, LDS_BYTES) != hipSuccess) { fprintf(stderr, "kernel_launch: hipFuncSetAttribute failed\n"); grid = -1; return; }
        int per_cu = 0;
        if (hipOccupancyMaxActiveBlocksPerMultiprocessor(&per_cu, (const void*)hymba_fwd, NWAVES * 64, LDS_BYTES) != hipSuccess || per_cu < 1)
            fprintf(stderr, "kernel_launch: note: occupancy query reports %d workgroups per CU\n", per_cu);
        (void)hipGetLastError();
        grid = cus;
    }
    if (grid < 0) return;
    if (hipMemsetAsync((char*)d_ws + WS_CTL, 0, CTL_ZERO_BYTES, stream) != hipSuccess) { fprintf(stderr, "kernel_launch: memset failed\n"); return; }
    Args a{};
    for (int i = 0; i < 13; ++i) a.in[i] = (const float*)d_in[i];
    a.out = (float*)d_out; a.ws = (unsigned char*)d_ws;
#if MK_SPLIT
    for (int p = 0; p < NPHASE; ++p) { a.ph_lo = p; a.ph_hi = p + 1; hipLaunchKernelGGL(hymba_fwd, dim3(grid), dim3(NWAVES * 64), LDS_BYTES, stream, a); }
#else
    a.ph_lo = 0; a.ph_hi = NPHASE;
    hipLaunchKernelGGL(hymba_fwd, dim3(grid), dim3(NWAVES * 64), LDS_BYTES, stream, a);
#endif
    const hipError_t le = hipPeekAtLastError();
    if (le != hipSuccess) fprintf(stderr, "kernel_launch: launch failed: %s\n", hipGetErrorName(le));
}
```

```cpp
#include <hip/hip_runtime.h>
#include <cstdio>
#include <cstdint>

#ifndef ATT_SD_B
#define ATT_SD_B 2
#endif
#ifndef ATT_SD_A
#define ATT_SD_A 1
#endif
#ifndef DUP_MASK
#define DUP_MASK 0
#endif
#define REP(k) for (int _r = 0; _r < (((DUP_MASK >> (k)) & 1) ? 2 : 1); ++_r)
#ifndef WGM_P1
#define WGM_P1 8
#endif
#ifndef WGM_P4
#define WGM_P4 8
#endif
#ifndef WGM_P8
#define WGM_P8 4
#endif
#ifndef WGM_P9
#define WGM_P9 4
#endif
#ifndef MK_SPLIT
#define MK_SPLIT 0
#endif

constexpr int BATCH = 4, SEQ = 4096, DM = 2048, T = BATCH * SEQ, DIN = 3072, HD = 128;
constexpr int NE = 16, CAP = 512, DFF = 4096, MS = BATCH * NE * CAP;
constexpr float EPS = 1e-6f;
constexpr int COL_QA = 0, COL_KA = 1024, COL_VA = 1280, COL_QB = 1536, COL_KB = 2560, COL_VB = 2816;
constexpr int NPHASE = 11;
constexpr float QSQ = 0.088388347648318440f * 1.4426950408889634f * 2048.f / 16.f;
constexpr float QS = 16.f, PSC = 8.f;
constexpr float HS = 16.f, WIS = 1024.f, OS = 32.f;
constexpr float XS = 16.f, WS = 1024.f, AS = 16.f, WDS = 2048.f;
static_assert(COL_VA - COL_KA == 256 && COL_VB - COL_KB == 256, "V sits 256 columns right of K");

constexpr size_t MiB = 1u << 20;
constexpr size_t WS_CTL = 0, CTL_ZERO_BYTES = 1 * MiB;
constexpr size_t WS_AFF = 1 * MiB;
constexpr size_t WS_IDX = 2 * MiB;
constexpr size_t WS_GATE = 3 * MiB;
constexpr size_t WS_SLOT = 4 * MiB;
constexpr size_t WS_RSTD = 5 * MiB;
constexpr size_t WS_RS = 6 * MiB;
constexpr size_t WS_ROPE = 7 * MiB;
constexpr size_t WS_WIN = 8 * MiB;
constexpr size_t WS_WOUT = 20 * MiB;
constexpr size_t WS_HN = 32 * MiB;
constexpr size_t WS_PROJ = 96 * MiB;
constexpr size_t WS_ATT = 192 * MiB;
constexpr size_t WS_Q8 = 256 * MiB;
constexpr size_t WS_K8 = 272 * MiB;
constexpr size_t WS_VT8 = 280 * MiB;
constexpr size_t WS_WG = 384 * MiB;
constexpr size_t WS_WU = 640 * MiB;
constexpr size_t WS_WD = 896 * MiB;
constexpr size_t WS_XG = 1152 * MiB;
constexpr size_t WS_H8 = 1216 * MiB;
constexpr size_t WS_ACT = 1280 * MiB;
constexpr size_t WS_EO = 1536 * MiB;
constexpr size_t WS_END = 1664 * MiB;
constexpr int CW_TMO = 0, CW_BAR = 4096;

constexpr int RING_BYTES = 131072;
constexpr int LDSCTL_OFF = 161792, MISC_OFF = LDSCTL_OFF + 320;
constexpr int LDS_BYTES = 163840;
constexpr int NWAVES = 8;

#define GAS __attribute__((address_space(1)))
#define LAS __attribute__((address_space(3)))
typedef unsigned short bf16;
typedef unsigned v4u __attribute__((ext_vector_type(4)));
typedef unsigned v2u __attribute__((ext_vector_type(2)));
typedef float f32x4 __attribute__((ext_vector_type(4)));
typedef GAS unsigned gu32;
#define RLX_AGENT __ATOMIC_RELAXED, __HIP_MEMORY_SCOPE_AGENT
#define LDS_WAIT() asm volatile("s_waitcnt lgkmcnt(0)" ::: "memory")
#define VM_WAIT() asm volatile("s_waitcnt vmcnt(0)" ::: "memory")
__device__ __forceinline__ unsigned cvt_pk_bf16(float lo, float hi) { unsigned r; asm volatile("v_cvt_pk_bf16_f32 %0, %1, %2" : "=v"(r) : "v"(lo), "v"(hi)); return r; }
__device__ __forceinline__ float clamp8(float v) { return __builtin_amdgcn_fmed3f(v, -448.f, 448.f); }
__device__ __forceinline__ unsigned pk4_fp8(float a, float b, float c, float d) {
    int w = 0; w = __builtin_amdgcn_cvt_pk_fp8_f32(clamp8(a), clamp8(b), w, false); w = __builtin_amdgcn_cvt_pk_fp8_f32(clamp8(c), clamp8(d), w, true); return (unsigned)w; }
__device__ __forceinline__ unsigned pk4_fp8_nc(float a, float b, float c, float d) { int w = 0; w = __builtin_amdgcn_cvt_pk_fp8_f32(a, b, w, false); w = __builtin_amdgcn_cvt_pk_fp8_f32(c, d, w, true); return (unsigned)w; }
__device__ __forceinline__ float bf_lo(unsigned w) { return __uint_as_float(w << 16); }
__device__ __forceinline__ float bf_hi(unsigned w) { return __uint_as_float(w & 0xffff0000u); }
__device__ __forceinline__ float wave_sum(float v) {
#pragma unroll
    for (int o = 1; o < 64; o <<= 1) v += __shfl_xor(v, o);
    return v;
}

namespace pg8 {
#define PG8_LAS __attribute__((address_space(3)))
typedef unsigned short bf16_t;
typedef short bf16x8 __attribute__((ext_vector_type(8)));
typedef float f32x4 __attribute__((ext_vector_type(4)));
typedef unsigned u32x4 __attribute__((ext_vector_type(4)));
typedef unsigned u32x2 __attribute__((ext_vector_type(2)));
typedef int i32x4 __attribute__((ext_vector_type(4)));
typedef int i32x8 __attribute__((ext_vector_type(8)));
constexpr int BM = 256, BK = 64, HALF = 128, HTB = HALF * BK * 2, STAGE_BYTES = 8 * HTB, NXCD = 8;

__host__ __device__ __forceinline__ int lds_byte(int r, int c) { const int st = (r >> 4) * 2 + (c >> 5), rr = r & 15, cc = c & 31, ob = rr * 64 + cc * 2; return st * 1024 + (ob ^ (((ob >> 9) & 1) << 5)); }
__host__ __device__ __forceinline__ void stage_rc(int b, int& R, int& C) { const int st = b / 1024, sb = b % 1024, swz = sb ^ (((sb >> 9) & 1) << 5); R = (st >> 1) * 16 + swz / 64; C = (st & 1) * 32 + (swz % 64) / 2; }
__host__ __device__ __forceinline__ int perm32(int rho) { const int n = rho >> 4, i = rho & 15; return 8 * (i >> 2) + 4 * n + (i & 3); }

struct Unit { int pm, pn; };
struct Gemm { const bf16_t* A; const bf16_t* Bt; int K, nM, nN; size_t bh, bt, be; const int* gidx; PG8_LAS int* gtab; };

struct StaticOrder {
    int nM, nN, nwg, G, c, i0 = 0, ni = 1 << 30, WGM = 4;
    __host__ __device__ void init(int nM_, int nN_, int G_, int c_) { nM = nM_; nN = nN_; nwg = nM * nN; G = G_; c = c_; }
    __host__ __device__ bool next(int i, Unit& u) const {
        if (i >= ni) return false;
        const long L = (long)(i + i0) * G + c; if (L >= nwg) return false;
        int wgid = (int)L; { const int q = nwg / NXCD, r = nwg % NXCD, xcd = wgid % NXCD, off = wgid / NXCD; wgid = (xcd < r ? xcd * (q + 1) : r * (q + 1) + (xcd - r) * q) + off; }
        const int nig = WGM * nN, gid = wgid / nig, fm = gid * WGM, gsz = (nM - fm) < WGM ? (nM - fm) : WGM;
        u.pm = fm + ((wgid % nig) % gsz); u.pn = (wgid % nig) / gsz; return true;
    }
    __device__ __forceinline__ void a_ready(const Unit&) const {}
    __device__ __forceinline__ void done(const Unit&) const {}
};

struct EpiBf16 {
    static constexpr bool PERM = true, HEADSPLIT = false, HAS_PRE = false;
    bf16_t* O; int ldc; float sc;
    __device__ __forceinline__ void operator()(const f32x4 (&acc)[2][2][4][2], const Unit& u, int wr, int wc, int fr, int fq) const {
        const int row0 = u.pm * BM + wr * 64 + fr, col0 = u.pn * BM + wc * 32 + 8 * fq;
#pragma unroll
        for (int ai = 0; ai < 2; ++ai)
#pragma unroll
            for (int m = 0; m < 4; ++m) { bf16_t* rowp = O + (size_t)(row0 + ai * HALF + m * 16) * ldc + col0;
#pragma unroll
                for (int bj = 0; bj < 2; ++bj) { const f32x4 v0 = acc[ai][bj][m][0] * sc, v1 = acc[ai][bj][m][1] * sc;
                    u32x4 w; w.x = cvt_pk_bf16(v0[0], v0[1]); w.y = cvt_pk_bf16(v0[2], v0[3]); w.z = cvt_pk_bf16(v1[0], v1[1]); w.w = cvt_pk_bf16(v1[2], v1[3]);
                    *(u32x4*)(rowp + bj * HALF) = w; } }
    }
};
typedef _Float16 h2 __attribute__((ext_vector_type(2)));
struct EpiProj {
    static constexpr bool PERM = true, HEADSPLIT = true, HAS_PRE = false;
    bf16_t* O; int ldc; const float* gq; const float* gk; PG8_LAS float* xch; const PG8_LAS float* ropetab;
    float sc;
    unsigned char* Q8; unsigned char* K8; unsigned char* VT8;
    __device__ __forceinline__ void operator()(const f32x4 (&acc)[2][2][4][2], const Unit& u, int wr, int wc, int fr, int fq) const {
        const int row0 = u.pm * BM + wr * 64 + fr, col0 = u.pn * BM + 128 * (wc >> 1) + 64 * (wc & 1) + 8 * fq;
        const bool rope = u.pn >= COL_QB / BM && u.pn < COL_VB / BM;
        if (u.pn == COL_VB / BM) {
            unsigned char* vbase = VT8 + ((size_t)(((u.pm >> 4) * 2 + (wc >> 1)) * HD + 64 * (wc & 1))) * SEQ;
            const unsigned loff = (unsigned)(8 * fq) * SEQ + (unsigned)((u.pm & 15) * BM + wr * 64 + fr);
#pragma unroll
            for (int ai = 0; ai < 2; ++ai)
#pragma unroll
                for (int m = 0; m < 4; ++m) {
#pragma unroll
                    for (int bj = 0; bj < 2; ++bj)
#pragma unroll
                        for (int n = 0; n < 2; ++n) { const f32x4 x = acc[ai][bj][m][n] * (QS * sc); const unsigned w = pk4_fp8(x[0], x[1], x[2], x[3]);
#pragma unroll
                            for (int e = 0; e < 4; ++e) vbase[(size_t)(32 * bj + 4 * n + e) * SEQ + (loff + (unsigned)(ai * HALF + m * 16))] = (unsigned char)(w >> (8 * e)); }
                    asm volatile("" ::: "memory"); }
            return;
        }
        if (!rope) {
#pragma unroll
            for (int ai = 0; ai < 2; ++ai)
#pragma unroll
                for (int m = 0; m < 4; ++m) { bf16_t* rowp = O + (size_t)(row0 + ai * HALF + m * 16) * ldc + col0;
#pragma unroll
                    for (int bj = 0; bj < 2; ++bj) { const f32x4 v0 = acc[ai][bj][m][0] * sc, v1 = acc[ai][bj][m][1] * sc;
                        u32x4 w; w.x = cvt_pk_bf16(v0[0], v0[1]); w.y = cvt_pk_bf16(v0[2], v0[3]); w.z = cvt_pk_bf16(v1[0], v1[1]); w.w = cvt_pk_bf16(v1[2], v1[3]);
                        *(u32x4*)(rowp + bj * 32) = w; } }
            return;
        }
        const int half = wc & 1;
        float ssq[2][4];
#pragma unroll
        for (int ai = 0; ai < 2; ++ai)
#pragma unroll
            for (int m = 0; m < 4; ++m) { float q = 0.f;
#pragma unroll
                for (int bj = 0; bj < 2; ++bj)
#pragma unroll
                    for (int n = 0; n < 2; ++n) { const f32x4 x = acc[ai][bj][m][n]; q += (x[0] * x[0] + x[1] * x[1]) + (x[2] * x[2] + x[3] * x[3]); }
                q += __shfl_xor(q, 16); q += __shfl_xor(q, 32); ssq[ai][m] = q;
                if (fq == 0) xch[(ai * HALF + wr * 64 + m * 16 + fr) * 4 + wc] = q; }
        asm volatile("s_waitcnt lgkmcnt(0)" ::: "memory"); __builtin_amdgcn_s_barrier(); asm volatile("" ::: "memory");
        const float* g = (u.pn >= COL_KB / BM) ? gk : gq;
        const f32x4 g1a = *(const f32x4*)(g + 64 * half + 8 * fq), g1b = *(const f32x4*)(g + 64 * half + 8 * fq + 4), g2a = *(const f32x4*)(g + 64 * half + 32 + 8 * fq), g2b = *(const f32x4*)(g + 64 * half + 32 + 8 * fq + 4);
#pragma unroll
        for (int ai = 0; ai < 2; ++ai)
#pragma unroll
            for (int m = 0; m < 4; ++m) {
                const int rl = ai * HALF + wr * 64 + m * 16 + fr, row = u.pm * BM + rl, srow = row & (SEQ - 1);
                const float tot = ssq[ai][m] + xch[rl * 4 + (wc ^ 1)];
                const float rstd = sc / sqrtf(tot * (sc * sc * (1.f / HD)) + EPS);
                const int pos = half ? (srow & 63) : (srow >> 6);
                const PG8_LAS f32x4* tb = (const PG8_LAS f32x4*)(ropetab + (pos * 32 + 8 * fq) * 2);
                f32x4 o1[2], o2[2];
#pragma unroll
                for (int n = 0; n < 2; ++n) { const f32x4 ga = n ? g1b : g1a, gb = n ? g2b : g2a; const f32x4 t0 = tb[2 * n], t1 = tb[2 * n + 1];
#pragma unroll
                    for (int e = 0; e < 4; ++e) { const float cs = (e < 2 ? t0 : t1)[2 * (e & 1)], sn = (e < 2 ? t0 : t1)[2 * (e & 1) + 1];
                        const float y1 = acc[ai][0][m][n][e] * rstd * ga[e], y2 = acc[ai][1][m][n][e] * rstd * gb[e];
                        o1[n][e] = y1 * cs - y2 * sn; o2[n][e] = y2 * cs + y1 * sn; } }
                unsigned char* rowp = (u.pn >= COL_KB / BM) ? K8 + (size_t)row * 256 + 128 * (wc >> 1) + 64 * half + 8 * fq
                                                            : Q8 + (size_t)row * 1024 + 128 * ((u.pn - COL_QB / BM) * 2 + (wc >> 1)) + 64 * half + 8 * fq;
                const float qs = (u.pn >= COL_KB / BM) ? QS : QSQ;
                u32x2 w; w.x = pk4_fp8(o1[0][0] * qs, o1[0][1] * qs, o1[0][2] * qs, o1[0][3] * qs); w.y = pk4_fp8(o1[1][0] * qs, o1[1][1] * qs, o1[1][2] * qs, o1[1][3] * qs);
                *(u32x2*)rowp = w;
                w.x = pk4_fp8(o2[0][0] * qs, o2[0][1] * qs, o2[0][2] * qs, o2[0][3] * qs); w.y = pk4_fp8(o2[1][0] * qs, o2[1][1] * qs, o2[1][2] * qs, o2[1][3] * qs);
                *(u32x2*)(rowp + 32) = w; }
    }
};
struct EpiResF32 {
    static constexpr bool PERM = false, HEADSPLIT = false, HAS_PRE = false;
    const float* base; float* C; int ldc;
    __device__ __forceinline__ void operator()(const f32x4 (&acc)[2][2][4][2], const Unit& u, int wr, int wc, int fr, int fq) const {
        const int row0 = u.pm * BM + wr * 64 + fr, col0 = u.pn * BM + wc * 32 + 4 * fq;
#pragma unroll
        for (int ai = 0; ai < 2; ++ai)
#pragma unroll
            for (int m = 0; m < 4; ++m) { const size_t off = (size_t)(row0 + ai * HALF + m * 16) * ldc + col0;
#pragma unroll
                for (int bj = 0; bj < 2; ++bj)
#pragma unroll
                    for (int n = 0; n < 2; ++n) { const f32x4 bs = *(const f32x4*)(base + off + bj * HALF + n * 16); *(f32x4*)(C + off + bj * HALF + n * 16) = bs + acc[ai][bj][m][n]; }
                asm volatile("" ::: "memory"); }
    }
};
__device__ __forceinline__ float silu_mul(float a, float u) { return a * u * __builtin_amdgcn_rcpf(1.0f + __builtin_amdgcn_exp2f(-1.4426950408889634f * a)); }
struct EpiSwiGlu8 {
    static constexpr bool PERM = true, HEADSPLIT = false, HAS_PRE = true;
    unsigned char* O; int ldc; float si, so; const float* rs;
    __device__ __forceinline__ void prefetch(const Unit& u, float (&pre)[8], int wr, int fr) const {
        const int row0 = u.pm * BM + wr * 64 + fr;
#pragma unroll
        for (int ai = 0; ai < 2; ++ai)
#pragma unroll
            for (int m = 0; m < 4; ++m) pre[ai * 4 + m] = rs[row0 + ai * HALF + m * 16];
    }
    __device__ __forceinline__ void operator()(const f32x4 (&acc)[2][2][4][2], const Unit& u, int wr, int wc, int fr, int fq, const float (&pre)[8]) const {
        const int row0 = u.pm * BM + wr * 64 + fr, col0 = u.pn * HALF + wc * 32 + 8 * fq;
#pragma unroll
        for (int ai = 0; ai < 2; ++ai)
#pragma unroll
            for (int m = 0; m < 4; ++m) { const int row = row0 + ai * HALF + m * 16; unsigned char* rowp = O + (size_t)row * ldc + col0;
                const float sg = si * pre[ai * 4 + m], k1 = -1.4426950408889634f * sg, k2 = sg * sg * so;
                float r[8];
#pragma unroll
                for (int n = 0; n < 2; ++n)
#pragma unroll
                    for (int e = 0; e < 4; ++e) { const float gg = acc[ai][0][m][n][e], uu = acc[ai][1][m][n][e];
                        r[4 * n + e] = (gg * uu) * (k2 * __builtin_amdgcn_rcpf(1.0f + __builtin_amdgcn_exp2f(k1 * gg))); }
                u32x2 w; w.x = pk4_fp8(r[0], r[1], r[2], r[3]); w.y = pk4_fp8(r[4], r[5], r[6], r[7]);
                *(u32x2*)rowp = w; }
    }
};

template <class Epi, class Sched, bool ALIGN_EPI = false, bool SP2 = false, bool FP8 = false, bool GATHER = false>
__device__ __forceinline__ void gemm_phase(PG8_LAS unsigned char* lds, const Gemm g, const Sched& S, const Epi& E) {
    int tid = threadIdx.x; asm volatile("" : "+v"(tid));
    const int wid = __builtin_amdgcn_readfirstlane(tid >> 6), lane = tid & 63, wr = wid >> 2, wc = wid & 3, fr = lane & 15, fq = lane >> 4;
    const int K = g.K, nt = K / BK;
    unsigned voffA[2], voffB[2]; int stR[2], stC[2];
#pragma unroll
    for (int i = 0; i < 2; ++i) { int R, C; stage_rc(tid * 16 + i * 8192, R, C); const int Rb = Epi::HEADSPLIT ? (128 * (R >> 6) + 64 * ((R >> 5) & 1) + perm32(R & 31)) : (Epi::PERM ? ((R & ~31) + perm32(R & 31)) : R);
        voffA[i] = (unsigned)(R * K + C) * 2u; voffB[i] = (unsigned)(Rb * K + C) * 2u; stR[i] = R; stC[i] = C; }
    const size_t kstep = (size_t)(BK * 2);
    const size_t hA = (size_t)HALF * K * 2, hB = g.bh;
    const size_t tstepA = 2 * hA;
    const unsigned ldsw = (unsigned)wid * 1024u;
    const int aoff = lds_byte(wr * 64 + fr, fq * 8), boff = lds_byte(wc * 32 + fr, fq * 8);
#define PG8_SA(b, h) (((b) * 2 + (h)) * HTB)
#define PG8_SB(b, h) ((4 + (b) * 2 + (h)) * HTB)
#define PG8_STAGE(bufoff, gbase, voff) do { _Pragma("unroll") for (int _i = 0; _i < 2; ++_i) \
        __builtin_amdgcn_global_load_lds((const unsigned*)((const char*)(gbase) + (voff)[_i]), (PG8_LAS unsigned*)(lds + (bufoff) + ldsw + _i * 8192), 16, 0, 0); } while (0)
#define PG8_LDA(dst, b, h) do { _Pragma("unroll") for (int m = 0; m < 4; ++m) _Pragma("unroll") for (int k = 0; k < 2; ++k) dst[m][k] = *(const PG8_LAS bf16x8*)(lds + PG8_SA(b, h) + aoff + m * 2048 + k * 1024); } while (0)
#define PG8_LDB(dst, b, h) do { _Pragma("unroll") for (int n = 0; n < 2; ++n) _Pragma("unroll") for (int k = 0; k < 2; ++k) dst[n][k] = *(const PG8_LAS bf16x8*)(lds + PG8_SB(b, h) + boff + n * 2048 + k * 1024); } while (0)
#define PG8_CAT(x) __builtin_shufflevector(__builtin_bit_cast(i32x4, (x)[0]), __builtin_bit_cast(i32x4, (x)[1]), 0, 1, 2, 3, 4, 5, 6, 7)
#define PG8_MMA(ai, bj, At, Bt) do { __builtin_amdgcn_s_setprio(1); _Pragma("unroll") for (int m = 0; m < 4; ++m) _Pragma("unroll") for (int n = 0; n < 2; ++n) { \
        if constexpr (FP8) { asm volatile("v_mfma_scale_f32_16x16x128_f8f6f4 %0, %1, %2, %0, %3, %3 op_sel_hi:[0,0,0]" : "+v"(acc[ai][bj][m][n]) : "v"(PG8_CAT(Bt[n])), "v"(PG8_CAT(At[m])), "v"(unit_scale)); } \
        else { _Pragma("unroll") for (int k = 0; k < 2; ++k) acc[ai][bj][m][n] = __builtin_amdgcn_mfma_f32_16x16x32_bf16(Bt[n][k], At[m][k], acc[ai][bj][m][n], 0, 0, 0); } } \
        __builtin_amdgcn_s_setprio(0); } while (0)
#define PG8_WAIT_V(n) asm volatile("s_waitcnt vmcnt(" #n ")" ::: "memory")
#define PG8_WAIT_L(n) asm volatile("s_waitcnt lgkmcnt(" #n ")" ::: "memory")
#define PG8_BAR __builtin_amdgcn_s_barrier()
#define PG8_SCHED __builtin_amdgcn_sched_barrier(0)
    Unit cur, nxt; int ui = 0;
    if (!S.next(0, cur)) return;
    const int unit_scale = 0x7f7f7f7f; (void)unit_scale;
    f32x4 acc[2][2][4][2];
#pragma unroll
    for (int a = 0; a < 2; ++a)
#pragma unroll
        for (int b = 0; b < 2; ++b)
#pragma unroll
            for (int m = 0; m < 4; ++m)
#pragma unroll
                for (int n = 0; n < 2; ++n) acc[a][b][m][n] = (f32x4){0.f, 0.f, 0.f, 0.f};
    bf16x8 At[4][2], B0[2][2], B1[2][2];
    const char* cA = GATHER ? (const char*)g.A : (const char*)g.A + (size_t)cur.pm * tstepA; const char* cB = (const char*)g.Bt + (size_t)(cur.pm >> 3) * g.be + (size_t)cur.pn * g.bt;
    S.a_ready(cur);
    unsigned gc[2][2], gn[2][2];
    if constexpr (GATHER) {
#pragma unroll
        for (int h = 0; h < 2; ++h)
#pragma unroll
            for (int i = 0; i < 2; ++i) { const int tok = g.gidx[cur.pm * BM + h * HALF + stR[i]]; gc[h][i] = (unsigned)(((((cur.pm >> 1) & 3) * SEQ + tok) * K + stC[i]) * 2); gn[h][i] = gc[h][i]; }
    }
#define PG8_OA(h, nx) (GATHER ? ((nx) ? gn[h] : gc[h]) : voffA)
#define PG8_HA(h) (GATHER ? (size_t)0 : (size_t)(h) * hA)
    float pre[8]; (void)pre;
    if constexpr (Epi::HAS_PRE) E.prefetch(cur, pre, wr, fr);
    if constexpr (SP2) {
        PG8_STAGE(PG8_SB(0, 0), cB, voffB); PG8_STAGE(PG8_SB(0, 1), cB + hB, voffB); PG8_STAGE(PG8_SA(0, 0), cA, PG8_OA(0, false)); PG8_STAGE(PG8_SA(0, 1), cA + PG8_HA(1), PG8_OA(1, false));
        if (wr == 1) PG8_BAR;
        PG8_WAIT_V(2); PG8_BAR;
        PG8_STAGE(PG8_SB(1, 0), cB + kstep, voffB); PG8_STAGE(PG8_SA(1, 0), cA + kstep, PG8_OA(0, false)); PG8_STAGE(PG8_SB(1, 1), cB + hB + kstep, voffB);
        PG8_WAIT_V(6); PG8_BAR;
    } else {
        PG8_STAGE(PG8_SB(0, 0), cB, voffB); PG8_STAGE(PG8_SA(0, 0), cA, PG8_OA(0, false)); PG8_STAGE(PG8_SB(0, 1), cB + hB, voffB); PG8_STAGE(PG8_SA(0, 1), cA + PG8_HA(1), PG8_OA(1, false));
        if (wr == 1) PG8_BAR;
        PG8_WAIT_V(4); PG8_BAR;
        PG8_STAGE(PG8_SB(1, 0), cB + kstep, voffB); PG8_STAGE(PG8_SA(1, 0), cA + kstep, PG8_OA(0, false)); PG8_STAGE(PG8_SB(1, 1), cB + hB + kstep, voffB);
        PG8_WAIT_V(6); PG8_BAR;
    }
    for (;;) {
        const bool has_next = S.next(ui + 1, nxt);
        if constexpr (GATHER) { if (has_next && wid == 0)
            __builtin_amdgcn_global_load_lds((const unsigned*)(g.gidx + nxt.pm * BM + lane * 4), (PG8_LAS unsigned*)(g.gtab + ((ui + 1) & 1) * BM), 16, 0, 0); }
        const char* nA = GATHER ? cA : (has_next ? (const char*)g.A + (size_t)nxt.pm * tstepA : cA); const char* nB = has_next ? (const char*)g.Bt + (size_t)(nxt.pm >> 3) * g.be + (size_t)nxt.pn * g.bt : cB;
        for (int t = 0; t < nt; t += 2) {
            const bool last = (t == nt - 2);
            const char* a1 = cA + (size_t)(t + 1) * kstep;
            const char* a2 = last ? nA : cA + (size_t)(t + 2) * kstep; const char* b2 = last ? nB : cB + (size_t)(t + 2) * kstep;
            const char* a3 = a2 + kstep; const char* b3 = b2 + kstep;
            if (last && has_next) S.a_ready(nxt);
            if constexpr (GATHER) { if (last && has_next) {
#pragma unroll
                for (int h = 0; h < 2; ++h)
#pragma unroll
                    for (int i = 0; i < 2; ++i) { const int tok = g.gtab[((ui + 1) & 1) * BM + h * HALF + stR[i]]; gn[h][i] = (unsigned)(((((nxt.pm >> 1) & 3) * SEQ + tok) * K + stC[i]) * 2); } } }
            if constexpr (SP2) {
            PG8_LDB(B0, 0, 0); PG8_LDB(B1, 0, 1); PG8_SCHED; PG8_LDA(At, 0, 0); PG8_STAGE(PG8_SA(1, 1), a1 + PG8_HA(1), PG8_OA(1, false));
            PG8_WAIT_V(8); PG8_WAIT_L(0); PG8_BAR; PG8_MMA(0, 0, At, B0); PG8_MMA(0, 1, At, B1); PG8_BAR; PG8_SCHED;
            PG8_LDA(At, 0, 1); PG8_STAGE(PG8_SB(0, 0), b2, voffB); PG8_STAGE(PG8_SB(0, 1), b2 + hB, voffB); PG8_STAGE(PG8_SA(0, 0), a2, PG8_OA(0, last));
            PG8_WAIT_V(8); PG8_WAIT_L(0); PG8_BAR; PG8_MMA(1, 0, At, B0); PG8_MMA(1, 1, At, B1); PG8_BAR; PG8_SCHED;
            PG8_LDB(B0, 1, 0); PG8_LDB(B1, 1, 1); PG8_SCHED; PG8_LDA(At, 1, 0); PG8_STAGE(PG8_SA(0, 1), a2 + PG8_HA(1), PG8_OA(1, last));
            PG8_WAIT_V(8); PG8_WAIT_L(0); PG8_BAR; PG8_MMA(0, 0, At, B0); PG8_MMA(0, 1, At, B1); PG8_BAR; PG8_SCHED;
            PG8_LDA(At, 1, 1); PG8_STAGE(PG8_SB(1, 0), b3, voffB); PG8_STAGE(PG8_SB(1, 1), b3 + hB, voffB); PG8_STAGE(PG8_SA(1, 0), a3, PG8_OA(0, last));
            PG8_WAIT_V(8); PG8_WAIT_L(0); PG8_BAR; PG8_MMA(1, 0, At, B0); PG8_MMA(1, 1, At, B1); PG8_BAR; PG8_SCHED;
            } else {
            PG8_LDB(B0, 0, 0); PG8_SCHED; PG8_LDA(At, 0, 0); PG8_STAGE(PG8_SA(1, 1), a1 + PG8_HA(1), PG8_OA(1, false));
            PG8_WAIT_L(8); PG8_BAR; PG8_WAIT_L(0); PG8_MMA(0, 0, At, B0); PG8_BAR; PG8_SCHED;
            PG8_LDB(B1, 0, 1); PG8_STAGE(PG8_SB(0, 0), b2, voffB);
            PG8_BAR; PG8_WAIT_L(0); PG8_MMA(0, 1, At, B1); PG8_BAR;
            PG8_LDA(At, 0, 1); PG8_STAGE(PG8_SA(0, 0), a2, PG8_OA(0, last));
            PG8_BAR; PG8_WAIT_L(0); PG8_MMA(1, 0, At, B0); PG8_BAR; PG8_SCHED;
            PG8_STAGE(PG8_SB(0, 1), b2 + hB, voffB);
            PG8_WAIT_V(6); PG8_BAR; PG8_MMA(1, 1, At, B1); PG8_BAR;
            PG8_LDB(B0, 1, 0); PG8_SCHED; PG8_LDA(At, 1, 0); PG8_STAGE(PG8_SA(0, 1), a2 + PG8_HA(1), PG8_OA(1, last));
            PG8_WAIT_L(8); PG8_BAR; PG8_WAIT_L(0); PG8_MMA(0, 0, At, B0); PG8_BAR; PG8_SCHED;
            PG8_LDB(B1, 1, 1); PG8_STAGE(PG8_SB(1, 0), b3, voffB);
            PG8_BAR; PG8_WAIT_L(0); PG8_MMA(0, 1, At, B1); PG8_BAR;
            PG8_LDA(At, 1, 1); PG8_STAGE(PG8_SA(1, 0), a3, PG8_OA(0, last));
            PG8_BAR; PG8_WAIT_L(0); PG8_MMA(1, 0, At, B0); PG8_BAR; PG8_SCHED;
            PG8_STAGE(PG8_SB(1, 1), b3 + hB, voffB);
            PG8_WAIT_V(6); PG8_BAR; PG8_MMA(1, 1, At, B1); PG8_BAR;
            }
        }
        if constexpr (ALIGN_EPI) { if (wr == 0) PG8_BAR; }
        if constexpr (FP8) asm volatile("s_nop 15\n\ts_nop 15" ::: "memory");
        if constexpr (Epi::HAS_PRE) E(acc, cur, wr, wc, fr, fq, pre); else E(acc, cur, wr, wc, fr, fq);
        S.done(cur);
        if (!has_next) break;
#pragma unroll
        for (int a = 0; a < 2; ++a)
#pragma unroll
            for (int b = 0; b < 2; ++b)
#pragma unroll
                for (int m = 0; m < 4; ++m)
#pragma unroll
                    for (int n = 0; n < 2; ++n) acc[a][b][m][n] = (f32x4){0.f, 0.f, 0.f, 0.f};
        cur = nxt; cA = nA; cB = nB; ++ui;
        if constexpr (GATHER) { gc[0][0] = gn[0][0]; gc[0][1] = gn[0][1]; gc[1][0] = gn[1][0]; gc[1][1] = gn[1][1]; }
        if constexpr (Epi::HAS_PRE) E.prefetch(cur, pre, wr, fr);
        if constexpr (ALIGN_EPI) { if (wr == 1) PG8_BAR; }
    }
    PG8_WAIT_V(0);
    if constexpr (!ALIGN_EPI) { if (wr == 0) PG8_BAR; }
    PG8_BAR;
#undef PG8_OA
#undef PG8_HA
#undef PG8_SA
#undef PG8_SB
#undef PG8_STAGE
#undef PG8_LDA
#undef PG8_LDB
#undef PG8_MMA
#undef PG8_CAT
#undef PG8_WAIT_V
#undef PG8_WAIT_L
#undef PG8_BAR
#undef PG8_SCHED
}
}

namespace att {
constexpr int D = 128, NW = 8, QBLK = 32, KVBLK = 64;
constexpr float SCALE = 0.088388347648318440f;
constexpr float THR = 8.f;
constexpr int LDQ = DIN, LDK = DIN, LDO = DM;
constexpr size_t SHM_V = KVBLK * D * 2, SHM_K = KVBLK * D * 2, SHM_ATTN = 2 * SHM_V + 2 * SHM_K + NW * 64 * 4;
using bf16x8 = __attribute__((ext_vector_type(8))) short;
using s16x4  = __attribute__((ext_vector_type(4))) short;
using f32x16 = __attribute__((ext_vector_type(16))) float;
using u32x4  = __attribute__((ext_vector_type(4))) unsigned;
#define KSWZ(row, colB) ((row) * 256 + ((colB) ^ (((row) & 7) << 4)))
#define SBAR() __builtin_amdgcn_sched_barrier(0)
__device__ __forceinline__ int crow(int r, int hi) { return (r & 3) + 8 * (r >> 2) + 4 * hi; }
__device__ __forceinline__ unsigned cvtpk(float lo, float hi) { unsigned r; asm volatile("v_cvt_pk_bf16_f32 %0, %1, %2" : "=v"(r) : "v"(lo), "v"(hi)); return r; }
__device__ __forceinline__ bf16x8 ld8(const bf16* p) { return *reinterpret_cast<const bf16x8*>(p); }

template <bool WIN>
__device__ __forceinline__ void partialSM(f32x16& p0, f32x16& p1, float& m_reg, float& mn, float& alpha, float fdb, float nslope) {
  constexpr float C = SCALE * 1.4426950408889634f;
  if constexpr (WIN) {
#pragma unroll
    for (int r = 0; r < 16; ++r) { const float cr = (float)((r & 3) + 8 * (r >> 2));
      const float d0 = __builtin_fabsf(fdb - cr), d1 = __builtin_fabsf(fdb - 32.f - cr);
      p0[r] = d0 <= 128.f ? fmaf(nslope, d0, p0[r]) : -1e30f;
      p1[r] = d1 <= 128.f ? fmaf(nslope, d1, p1[r]) : -1e30f; }
  }
  float pmax = p0[0]; for (int r = 1; r < 16; ++r) pmax = fmaxf(pmax, p0[r]); for (int r = 0; r < 16; ++r) pmax = fmaxf(pmax, p1[r]);
  { auto rr = __builtin_amdgcn_permlane32_swap(__float_as_uint(pmax), __float_as_uint(pmax), false, false);
    pmax = fmaxf(__uint_as_float(rr[0]), __uint_as_float(rr[1])); }
  if (__builtin_expect(__all(pmax - m_reg <= THR / SCALE), 1)) { mn = m_reg; alpha = 1.f; }
  else { mn = fmaxf(m_reg, pmax); alpha = __builtin_amdgcn_exp2f((m_reg - mn) * C); m_reg = mn; }
  float mnC = -mn * C;
  for (int r = 0; r < 16; ++r) p0[r] = fmaf(p0[r], C, mnC); for (int r = 0; r < 16; ++r) p1[r] = fmaf(p1[r], C, mnC);
  for (int r = 0; r < 16; ++r) p0[r] = __builtin_amdgcn_exp2f(p0[r]);
}
__device__ __forceinline__ void finishSM(f32x16& p0, f32x16& p1, float alpha, float& l_reg, bf16x8& pa0, bf16x8& pa1, bf16x8& pa2, bf16x8& pa3) {
  for (int r = 0; r < 16; ++r) p1[r] = __builtin_amdgcn_exp2f(p1[r]);
  float ps = 0; for (int r = 0; r < 16; ++r) ps += p0[r]; for (int r = 0; r < 16; ++r) ps += p1[r];
  { auto rr = __builtin_amdgcn_permlane32_swap(__float_as_uint(ps), __float_as_uint(ps), false, false);
    ps = __uint_as_float(rr[0]) + __uint_as_float(rr[1]); }
  l_reg = l_reg * alpha + ps;
#define PK4(P, BASE, OUT) do { unsigned a0 = cvtpk(P[BASE + 0], P[BASE + 1]), a1 = cvtpk(P[BASE + 2], P[BASE + 3]);   \
    unsigned b0 = cvtpk(P[BASE + 4], P[BASE + 5]), b1 = cvtpk(P[BASE + 6], P[BASE + 7]);                              \
    auto r0 = __builtin_amdgcn_permlane32_swap(a0, b0, false, false); auto r1 = __builtin_amdgcn_permlane32_swap(a1, b1, false, false); \
    u32x4 w = {r0[0], r1[0], r0[1], r1[1]}; OUT = *reinterpret_cast<bf16x8*>(&w); } while (0)
  PK4(p0, 0, pa0); PK4(p0, 8, pa1); PK4(p1, 0, pa2); PK4(p1, 8, pa3);
#undef PK4
}
__device__ __forceinline__ void qkt(f32x16& p0, f32x16& p1, const bf16* Ks, const bf16x8* qr, int r32, int hi) {
  p0 = f32x16{}; p1 = f32x16{};
  for (int d0 = 0; d0 < 8; ++d0) { int cb = (d0 * 16 + hi * 8) * 2;
    bf16x8 b0 = *reinterpret_cast<const bf16x8*>((const char*)Ks + KSWZ(r32, cb));
    bf16x8 b1 = *reinterpret_cast<const bf16x8*>((const char*)Ks + KSWZ(32 + r32, cb));
    p0 = __builtin_amdgcn_mfma_f32_32x32x16_bf16(b0, qr[d0], p0, 0, 0, 0);
    p1 = __builtin_amdgcn_mfma_f32_32x32x16_bf16(b1, qr[d0], p1, 0, 0, 0); }
}
__device__ __forceinline__ int v_st(int k, int c) { const int kk = (k & ~0xC) | ((k & 4) << 1) | ((k & 8) >> 1); return ((kk >> 3) * 4 + (c >> 5)) * 512 + ((kk & 7) * 32 + (c & 31)) * 2; }
__device__ __forceinline__ int v_rd_base(int lane) { return ((lane & 3) << 3) | (((lane >> 2) & 3) << 6) | (((lane >> 4) & 1) << 5) | (((lane >> 5) & 1) << 8); }
constexpr int v_rd_off(int d0, int ks, int half) { return d0 * 512 + ks * 4096 + half * 2048; }
template <int OFF> __device__ __forceinline__ s16x4 tr_read(int vb) {
  s16x4 r; asm volatile("ds_read_b64_tr_b16 %0, %1 offset:%2" : "=&v"(r) : "v"(vb), "i"(OFF) : "memory"); return r;
}
template <int D0> __device__ __forceinline__ void pv_one(f32x16& od, int vb, bf16x8 pa0, bf16x8 pa1, bf16x8 pa2, bf16x8 pa3) {
  const s16x4 l0 = tr_read<v_rd_off(D0, 0, 0)>(vb), h0 = tr_read<v_rd_off(D0, 0, 1)>(vb), l1 = tr_read<v_rd_off(D0, 1, 0)>(vb), h1 = tr_read<v_rd_off(D0, 1, 1)>(vb);
  const s16x4 l2 = tr_read<v_rd_off(D0, 2, 0)>(vb), h2 = tr_read<v_rd_off(D0, 2, 1)>(vb), l3 = tr_read<v_rd_off(D0, 3, 0)>(vb), h3 = tr_read<v_rd_off(D0, 3, 1)>(vb);
  asm volatile("s_waitcnt lgkmcnt(0)" ::: "memory"); SBAR();
#define PK(L, H) (bf16x8){L[0], L[1], L[2], L[3], H[0], H[1], H[2], H[3]}
  od = __builtin_amdgcn_mfma_f32_32x32x16_bf16(pa0, PK(l0, h0), od, 0, 0, 0);
  od = __builtin_amdgcn_mfma_f32_32x32x16_bf16(pa1, PK(l1, h1), od, 0, 0, 0);
  od = __builtin_amdgcn_mfma_f32_32x32x16_bf16(pa2, PK(l2, h2), od, 0, 0, 0);
  od = __builtin_amdgcn_mfma_f32_32x32x16_bf16(pa3, PK(l3, h3), od, 0, 0, 0);
#undef PK
}
__device__ __forceinline__ void pv_d0(f32x16* o, int vb, bf16x8 pa0, bf16x8 pa1, bf16x8 pa2, bf16x8 pa3) {
  pv_one<0>(o[0], vb, pa0, pa1, pa2, pa3); pv_one<1>(o[1], vb, pa0, pa1, pa2, pa3); pv_one<2>(o[2], vb, pa0, pa1, pa2, pa3); pv_one<3>(o[3], vb, pa0, pa1, pa2, pa3);
}

template <bool WIN, int SDEPTH>
__device__ __forceinline__ void attn_body(const bf16* __restrict__ Qb, const bf16* __restrict__ Kh, unsigned char* __restrict__ Ob, int NT, char* lds,
                                          int qrel0, float slope, float sink) {
  int tid = threadIdx.x; asm volatile("" : "+v"(tid));
  const int wid = tid >> 6, lane = tid & 63, r32 = lane & 31, hi = lane >> 5;
  bf16* V_lds = (bf16*)lds; bf16* K_lds = (bf16*)(lds + 2 * SHM_V);
  float* ws = (float*)(lds + 2 * SHM_V + 2 * SHM_K) + wid * 64; float* li_l = ws; float* al_l = ws + 32;
  float m_reg = WIN ? sink * (1.0f / SCALE) : -1e30f, l_reg = WIN ? 1.0f : 0.f; f32x16 o[4] = {}; bf16x8 qr[8];
  const float nslope = -slope * (1.0f / SCALE);
  const float fd0 = (float)(qrel0 + wid * QBLK + r32 - 4 * hi);
  const bf16* Qw = Qb + (long)(wid * QBLK + r32) * LDQ + hi * 8;
#pragma unroll
  for (int d0 = 0; d0 < 8; ++d0) qr[d0] = ld8(Qw + d0 * 16);
  const int sr = tid >> 4, sc = (tid & 15) * 8, vst0 = v_st(sr, sc), vst1 = v_st(32 + sr, sc);
  const int vb0 = (int)(uintptr_t)V_lds + v_rd_base(lane);
  struct { bf16x8 vs0, vs1, ks0, ks1; } sr_[SDEPTH];
  const unsigned loff = (unsigned)(sr * LDK + sc) * 2u;
#define SLOAD(i, k0) do { const GAS char* tb = (const GAS char*)Kh + (size_t)(k0) * (LDK * 2); const GAS char* tb2 = tb + (size_t)32 * LDK * 2; \
    sr_[i].vs0 = *(const GAS bf16x8*)(tb + loff + 512); sr_[i].vs1 = *(const GAS bf16x8*)(tb2 + loff + 512); \
    sr_[i].ks0 = *(const GAS bf16x8*)(tb + loff); sr_[i].ks1 = *(const GAS bf16x8*)(tb2 + loff); } while (0)
#define SWRITE(b, i) do { *(bf16x8*)((char*)V_lds + (b) * SHM_V + vst0) = sr_[i].vs0;          \
    *(bf16x8*)((char*)V_lds + (b) * SHM_V + vst1) = sr_[i].vs1; int kc = sc * 2;               \
    *(bf16x8*)((char*)K_lds + (b) * SHM_K + KSWZ(sr, kc)) = sr_[i].ks0;                       \
    *(bf16x8*)((char*)K_lds + (b) * SHM_K + KSWZ(32 + sr, kc)) = sr_[i].ks1; } while (0)
#define SWAIT() do { if constexpr (SDEPTH == 2) asm volatile("s_waitcnt vmcnt(4)" ::: "memory"); else asm volatile("s_waitcnt vmcnt(0)" ::: "memory"); } while (0)
#define RESC(a) do { if (__any((a) < 1.f)) { if (hi == 0) al_l[r32] = (a); asm volatile("s_waitcnt lgkmcnt(0)" ::: "memory"); \
    for (int d = 0; d < 4; ++d) for (int r = 0; r < 16; ++r) o[d][r] *= al_l[crow(r, hi)]; } } while (0)
  f32x16 pA0, pA1, pB0, pB1; float mnA, mnB, alA, alB; bf16x8 pa0, pa1, pa2, pa3;
  constexpr int SE = 0, SO = SDEPTH - 1;
  const int wq0 = WIN ? __builtin_amdgcn_readfirstlane(qrel0 + wid * QBLK) : 0;
#define NEED(t) (!WIN || (64 * (t) <= wq0 + 159 && 64 * (t) + 63 >= wq0 - 128))
  bool nA = NEED(0), nB = true;
  SLOAD(SE, 0); asm volatile("s_waitcnt vmcnt(0)" ::: "memory"); SWRITE(0, SE); __syncthreads();
  if (nA) { qkt(pA0, pA1, K_lds, qr, r32, hi); partialSM<WIN>(pA0, pA1, m_reg, mnA, alA, fd0, nslope); }
  SLOAD(SO, KVBLK); if constexpr (SDEPTH == 2) { if (2 < NT) SLOAD(SE, 2 * KVBLK); }
  SWAIT(); SWRITE(1, SO); __syncthreads();
  for (int j = 1; j + 1 < NT; j += 2) {
    nB = NEED(j);
    SBAR(); if (nB) qkt(pB0, pB1, (bf16*)((char*)K_lds + SHM_K), qr, r32, hi);
    if (nA) finishSM(pA0, pA1, alA, l_reg, pa0, pa1, pa2, pa3); SBAR();
    SLOAD(SO, (j + SDEPTH) * KVBLK); SBAR();
    if (nA) pv_d0(o, vb0, pa0, pa1, pa2, pa3); if (nB) partialSM<WIN>(pB0, pB1, m_reg, mnB, alB, fd0 - 64.f * (float)j, nslope);
    __syncthreads(); SWAIT(); SWRITE(0, SE);
    if (nB) RESC(alB); __syncthreads();
    nA = NEED(j + 1);
    SBAR(); if (nA) qkt(pA0, pA1, K_lds, qr, r32, hi);
    if (nB) finishSM(pB0, pB1, alB, l_reg, pa0, pa1, pa2, pa3); SBAR();
    if (SDEPTH == 1 || j + 3 < NT) SLOAD(SE, (j + 1 + SDEPTH) * KVBLK); SBAR();
    if (nB) pv_d0(o, vb0 + (int)SHM_V, pa0, pa1, pa2, pa3); if (nA) partialSM<WIN>(pA0, pA1, m_reg, mnA, alA, fd0 - 64.f * (float)(j + 1), nslope);
    __syncthreads(); SWAIT(); SWRITE(1, SO);
    if (nA) RESC(alA); __syncthreads();
  }
  nB = NEED(NT - 1);
  SBAR(); if (nB) qkt(pB0, pB1, (bf16*)((char*)K_lds + SHM_K), qr, r32, hi);
  if (nA) finishSM(pA0, pA1, alA, l_reg, pa0, pa1, pa2, pa3); SBAR();
  if (nA) pv_d0(o, vb0, pa0, pa1, pa2, pa3); if (nB) partialSM<WIN>(pB0, pB1, m_reg, mnB, alB, fd0 - 64.f * (float)(NT - 1), nslope);
  __syncthreads(); if (nB) { RESC(alB);
  finishSM(pB0, pB1, alB, l_reg, pa0, pa1, pa2, pa3); SBAR();
  pv_d0(o, vb0 + (int)SHM_V, pa0, pa1, pa2, pa3); }
#undef NEED
  if (hi == 0) li_l[r32] = l_reg; asm volatile("s_waitcnt lgkmcnt(0)" ::: "memory");
  float rli[16];
#pragma unroll
  for (int r = 0; r < 16; ++r) rli[r] = __builtin_amdgcn_rcpf(li_l[crow(r, hi)]);
  unsigned char* Ow = Ob + (long)(wid * QBLK) * LDO + 4 * r32;
#pragma unroll
  for (int r = 0; r < 16; ++r) { const int orow = crow(r, hi); const float sr = rli[r] * OS;
    *(unsigned*)(Ow + (long)orow * LDO) = pk4_fp8(o[0][r] * sr, o[1][r] * sr, o[2][r] * sr, o[3][r] * sr); }
#undef SLOAD
#undef SWRITE
#undef SWAIT
#undef RESC
}

typedef int i32x8 __attribute__((ext_vector_type(8)));
typedef int i32x4 __attribute__((ext_vector_type(4)));
constexpr int SHM8 = 8192;
__device__ __forceinline__ i32x8 cat8(i32x4 a, i32x4 b) { return __builtin_shufflevector(a, b, 0, 1, 2, 3, 4, 5, 6, 7); }
__device__ __forceinline__ void mfma8(f32x16& acc, i32x8 a, i32x8 b) {
  acc = __builtin_amdgcn_mfma_scale_f32_32x32x64_f8f6f4(a, b, acc, 0, 0, 0, 0x7f7f7f7f, 0, 0x7f7f7f7f);
}
__device__ __forceinline__ void mfma8qk(f32x16& d, const f32x16& c, i32x8 a, i32x8 b) {
  d = __builtin_amdgcn_mfma_scale_f32_32x32x64_f8f6f4(a, b, c, 0, 0, 0, 0x7f7f7f7f, 0, 0x74747474);
}
template <int SDEPTH>
__device__ __forceinline__ void attn_body8(const unsigned char* __restrict__ Qb, const unsigned char* __restrict__ Kh, const unsigned char* __restrict__ VTh, unsigned char* __restrict__ Ob, int NT, char* lds) {
  constexpr float XMAX = 3.0f + 4.0f * 1.4426950408889634f;
  static_assert(PSC == 8.f, "the exponent shift below is log2(PSC) = 3");
  int tid = threadIdx.x; asm volatile("" : "+v"(tid));
  const int wid = __builtin_amdgcn_readfirstlane(tid >> 6), lane = tid & 63, r32 = lane & 31, hi = lane >> 5;
  char* K_lds = lds; char* V_lds = lds + 4 * SHM8;
  float* ws = (float*)(lds + 6 * SHM8) + wid * 64; float* al_l = ws + 32;
  f32x16 negm = {}; f32x16 o[4] = {}, o5 = {};
  char* Q_lds = lds + 6 * SHM8 + 2048;
  __syncthreads();
#pragma unroll
  for (int i = 0; i < 4; ++i) { const int idx = tid + 512 * i, row = idx >> 3, ch = idx & 7;
    *(i32x4*)(Q_lds + row * 128 + ((ch ^ ((row >> 1) & 7)) << 4)) = *(const GAS i32x4*)(Qb + (size_t)row * 1024 + 16 * ch); }
  const char* Qw = Q_lds + wid * 4096;
  const int skey = tid >> 3, skc = tid & 7, sd = tid >> 2, svc = tid & 3;
  const unsigned vst0 = (unsigned)(sd * 64 + ((((svc >> 1)) ^ ((sd >> 2) & 3)) << 4) + 8 * (svc & 1)), vst1 = (unsigned)(sd * 64 + (((2 + (svc >> 1)) ^ ((sd >> 2) & 3)) << 4) + 8 * (svc & 1));
  const unsigned kgo = (unsigned)(skey * 256 + 16 * (skc ^ ((skey >> 1) & 7)));
  const unsigned kdst = (unsigned)(uintptr_t)K_lds + (unsigned)wid * 1024u;
  const unsigned vgo = (unsigned)(sd * SEQ + 16 * svc);
  struct { i32x4 v; } sr_[SDEPTH];
#define SLOAD(i, k0) do { __builtin_amdgcn_global_load_lds((const GAS unsigned*)((const GAS char*)Kh + (size_t)(k0) * 256 + kgo), (LAS unsigned*)(kdst + ((((unsigned)(k0)) >> 6) & 3u) * (unsigned)SHM8), 16, 0, 0); \
    sr_[i].v = *(const GAS i32x4*)((const GAS char*)VTh + (k0) + vgo); } while (0)
#define SWRITE(b, i) do { \
    *(long long*)(V_lds + (b) * SHM8 + vst0) = ((long long)(unsigned)sr_[i].v[2] << 32) | (unsigned)sr_[i].v[0];   \
    *(long long*)(V_lds + (b) * SHM8 + vst1) = ((long long)(unsigned)sr_[i].v[3] << 32) | (unsigned)sr_[i].v[1]; } while (0)
#define SWAIT() do { if constexpr (SDEPTH == 2) asm volatile("s_waitcnt vmcnt(2)" ::: "memory"); else asm volatile("s_waitcnt vmcnt(0)" ::: "memory"); } while (0)
#define RESC(a) do { if (__any((a) < 1.f)) { if (hi == 0) al_l[r32] = (a); asm volatile("s_waitcnt lgkmcnt(0)" ::: "memory"); \
    for (int r = 0; r < 16; ++r) { const float f_ = al_l[crow(r, hi)]; o[0][r] *= f_; o[1][r] *= f_; o[2][r] *= f_; o[3][r] *= f_; o5[r] *= f_; } } } while (0)
  const int ks = (r32 >> 1) & 7, vs = (r32 >> 2) & 3;
  const int ka0 = r32 * 128 + (((2 * hi) ^ ks) << 4), ka1 = r32 * 128 + (((2 * hi + 1) ^ ks) << 4), ka2 = r32 * 128 + (((4 + 2 * hi) ^ ks) << 4), ka3 = r32 * 128 + (((5 + 2 * hi) ^ ks) << 4);
  const int va0 = r32 * 64 + (((2 * hi) ^ vs) << 4), va1 = r32 * 64 + (((2 * hi + 1) ^ vs) << 4);
#define QKT8(p0, p1, Kb) do { \
    { const i32x8 qa = cat8(*(const i32x4*)(Qw + ka0), *(const i32x4*)(Qw + ka1)); \
      mfma8qk(p0, negm, cat8(*(const i32x4*)((Kb) + ka0), *(const i32x4*)((Kb) + ka1)), qa); mfma8qk(p1, negm, cat8(*(const i32x4*)((Kb) + 4096 + ka0), *(const i32x4*)((Kb) + 4096 + ka1)), qa); } \
    { const i32x8 qb = cat8(*(const i32x4*)(Qw + ka2), *(const i32x4*)(Qw + ka3)); \
      mfma8qk(p0, p0, cat8(*(const i32x4*)((Kb) + ka2), *(const i32x4*)((Kb) + ka3)), qb); mfma8qk(p1, p1, cat8(*(const i32x4*)((Kb) + 4096 + ka2), *(const i32x4*)((Kb) + 4096 + ka3)), qb); } } while (0)
#define PV8(Vb, pk) do { _Pragma("unroll") for (int d0 = 0; d0 < 4; ++d0) mfma8(o[d0], pk, cat8(*(const i32x4*)((Vb) + d0 * 2048 + va0), *(const i32x4*)((Vb) + d0 * 2048 + va1))); \
    { int c38 = 0x38383838; asm volatile("" : "+v"(c38)); const i32x8 ones = {c38, c38, c38, c38, c38, c38, c38, c38}; mfma8(o5, pk, ones); } } while (0)
#define PSM8(p0, p1, alpha, FIRST) do { float pmax = p0[0]; for (int r = 1; r < 16; ++r) pmax = fmaxf(pmax, p0[r]); for (int r = 0; r < 16; ++r) pmax = fmaxf(pmax, p1[r]); \
    { auto rr = __builtin_amdgcn_permlane32_swap(__float_as_uint(pmax), __float_as_uint(pmax), false, false); pmax = fmaxf(__uint_as_float(rr[0]), __uint_as_float(rr[1])); } \
    alpha = 1.f; \
    if (FIRST || !__builtin_expect(__all(pmax <= XMAX), 1)) { const float dl = FIRST ? (pmax - 3.0f) : fmaxf(pmax - 3.0f, 0.f); alpha = __builtin_amdgcn_exp2f(-dl); \
      for (int r = 0; r < 16; ++r) { p0[r] -= dl; p1[r] -= dl; negm[r] -= dl; } } \
    for (int r = 0; r < 16; ++r) p0[r] = __builtin_amdgcn_exp2f(p0[r]); } while (0)
#define FSM8(p0, p1, pk) do { for (int r = 0; r < 16; ++r) p1[r] = __builtin_amdgcn_exp2f(p1[r]); \
    _Pragma("unroll") for (int w = 0; w < 4; ++w) { pk[w] = (int)pk4_fp8_nc(p0[4 * w], p0[4 * w + 1], p0[4 * w + 2], p0[4 * w + 3]); pk[4 + w] = (int)pk4_fp8_nc(p1[4 * w], p1[4 * w + 1], p1[4 * w + 2], p1[4 * w + 3]); } } while (0)
  f32x16 pA0, pA1, pB0, pB1; float alA, alB; i32x8 pk;
  constexpr int SE = 0, SO = SDEPTH - 1;
  __syncthreads();
  SLOAD(SE, 0); asm volatile("s_waitcnt vmcnt(0)" ::: "memory"); SWRITE(0, SE); __syncthreads();
  QKT8(pA0, pA1, K_lds); PSM8(pA0, pA1, alA, true);
  SLOAD(SO, KVBLK); if constexpr (SDEPTH == 2) { if (2 < NT) SLOAD(SE, 2 * KVBLK); }
  SWAIT(); SWRITE(1, SO); __syncthreads();
  for (int j = 1; j + 1 < NT; j += 2) {
    SBAR(); QKT8(pB0, pB1, K_lds + (j & 3) * SHM8);
    FSM8(pA0, pA1, pk); SBAR();
    SLOAD(SO, (j + SDEPTH) * KVBLK); SBAR();
    PV8(V_lds, pk); PSM8(pB0, pB1, alB, false);
    __syncthreads(); SWAIT(); SWRITE(0, SE);
    RESC(alB); __syncthreads();
    SBAR(); QKT8(pA0, pA1, K_lds + ((j + 1) & 3) * SHM8);
    FSM8(pB0, pB1, pk); SBAR();
    if (SDEPTH == 1 || j + 3 < NT) SLOAD(SE, (j + 1 + SDEPTH) * KVBLK); SBAR();
    PV8(V_lds + SHM8, pk); PSM8(pA0, pA1, alA, false);
    __syncthreads(); SWAIT(); SWRITE(1, SO);
    RESC(alA); __syncthreads();
  }
  SBAR(); QKT8(pB0, pB1, K_lds + ((NT - 1) & 3) * SHM8);
  FSM8(pA0, pA1, pk); SBAR();
  PV8(V_lds, pk); PSM8(pB0, pB1, alB, false);
  __syncthreads(); RESC(alB);
  FSM8(pB0, pB1, pk); SBAR();
  PV8(V_lds + SHM8, pk);
  unsigned char* Ow = Ob + (long)(wid * QBLK) * LDO + 4 * r32;
#pragma unroll
  for (int r = 0; r < 16; ++r) { const int orow = crow(r, hi); const float rl = __builtin_amdgcn_rcpf(o5[r] * QS);
    const float sr = rl * OS; *(unsigned*)(Ow + (long)orow * LDO) = pk4_fp8(o[0][r] * sr, o[1][r] * sr, o[2][r] * sr, o[3][r] * sr); }
#undef SLOAD
#undef SWRITE
#undef SWAIT
#undef RESC
#undef QKT8
#undef PV8
#undef PSM8
#undef FSM8
}
#undef KSWZ
#undef SBAR
}

#define XB_TMO      128
#define XB_XCNT(j)  (256  + 64 * (j))
#define XB_XSUB(j)  (1280 + 64 * (j))
#define XB_XGEN(j)  (2304 + 64 * (j))
#define XB_TOP      3328
#define XB_TOPGEN   3392
#define XCD_BAR_WORDS 3456
#define XB_SPIN_CAP (1u << 18)
__device__ __forceinline__ unsigned xb_ld(unsigned* p)              { return __hip_atomic_load(p, __ATOMIC_RELAXED, __HIP_MEMORY_SCOPE_AGENT); }
__device__ __forceinline__ unsigned xb_add(unsigned* p, unsigned v) { return __hip_atomic_fetch_add(p, v, __ATOMIC_RELAXED, __HIP_MEMORY_SCOPE_AGENT); }
__device__ __forceinline__ unsigned xb_xcc_id() { return (unsigned)__builtin_amdgcn_s_getreg((3 << 11) | 20) & 0xFu; }
#define XB_SPIN(cond, bar) do { unsigned _sp = 0; while (cond) { __builtin_amdgcn_s_sleep(1); \
    if ((++_sp & 255u) == 0u) { if (xb_ld(&(bar)[XB_TMO])) break; if (_sp > XB_SPIN_CAP) { atomicAdd(&(bar)[XB_TMO], 1u); break; } } } } while (0)
struct XcdBarrier { unsigned* bar; unsigned x; volatile LAS unsigned* st; };
__device__ __forceinline__ XcdBarrier xcd_barrier_post(unsigned* bar, volatile LAS unsigned* st) {
    XcdBarrier b; b.bar = bar; b.x = xb_xcc_id(); b.st = st;
    if (threadIdx.x == 0) (void)xb_add(&bar[XB_XCNT(b.x)], 1u);
    return b;
}
__device__ __forceinline__ void xcd_barrier_complete(unsigned* bar, unsigned x, unsigned& nloc, unsigned& nx) {
    const unsigned G = gridDim.x * gridDim.y * gridDim.z;
    unsigned sum, cnt, mine, sp = 0u;
    for (;;) {
        sum = 0u; cnt = 0u; mine = 0u;
#pragma unroll
        for (unsigned j = 0; j < 16; ++j) { const unsigned c = xb_ld(&bar[XB_XCNT(j)]); sum += c; cnt += (c > 0u) ? 1u : 0u; mine = (j == x) ? c : mine; }
        if (sum == G) break;
        __builtin_amdgcn_s_sleep(1);
        if ((++sp & 255u) == 0u) { if (xb_ld(&bar[XB_TMO])) break; if (sp > XB_SPIN_CAP) { atomicAdd(&bar[XB_TMO], 1u); break; } }
    }
    nloc = mine > 0u ? mine : 1u; nx = cnt > 0u ? cnt : 1u;
}
__device__ __forceinline__ void xcd_barrier(const XcdBarrier& b) {
    asm volatile("s_waitcnt vmcnt(0)" ::: "memory");
    __syncthreads();
    if (threadIdx.x == 0) {
        unsigned* bar = b.bar;
        __builtin_amdgcn_s_waitcnt(0);
        unsigned nloc = b.st[0], nx = b.st[1];
        if (nloc == 0u) { xcd_barrier_complete(bar, b.x, nloc, nx); b.st[0] = nloc; b.st[1] = nx; }
        const unsigned old = xb_add(&bar[XB_XSUB(b.x)], 1u);
        const unsigned gen = old / nloc;
        if (old + 1u == (gen + 1u) * nloc) {
            __builtin_amdgcn_fence(__ATOMIC_RELEASE, "agent");
            asm volatile("s_waitcnt vmcnt(0)" ::: "memory");
            const unsigned og = xb_add(&bar[XB_TOP], 1u);
            const unsigned tg = og / nx;
            if (og + 1u == (tg + 1u) * nx) xb_add(&bar[XB_TOPGEN], 1u);
            else XB_SPIN(xb_ld(&bar[XB_TOPGEN]) == tg, bar);
            __builtin_amdgcn_fence(__ATOMIC_ACQUIRE, "agent");
            xb_add(&bar[XB_XGEN(b.x)], 1u);
            asm volatile("s_waitcnt vmcnt(0)" ::: "memory");
        } else {
            XB_SPIN(xb_ld(&bar[XB_XGEN(b.x)]) == gen, bar);
            __builtin_amdgcn_fence(__ATOMIC_ACQUIRE, "agent");
            asm volatile("s_waitcnt vmcnt(0)" ::: "memory");
        }
    }
    __syncthreads();
}

__device__ __forceinline__ unsigned f2bf(float f) { unsigned u = __builtin_bit_cast(unsigned, f); return (u + 0x7fffu + ((u >> 16) & 1u)) >> 16; }
__device__ __forceinline__ unsigned pk2(float lo, float hi) { return f2bf(lo) | (f2bf(hi) << 16); }
__device__ __forceinline__ void transpose_item(const float* W, int K, int N, bf16* WT, LAS float* scr, int item, int lane) {
    const int nblk = N / 32, kb = item / nblk, nb = item % nblk, k0 = 64 * kb, n0 = 32 * nb;
    const int kr = lane >> 3, c4 = (lane & 7) * 4;
    const float* src = W + (size_t)(k0 + kr) * N + n0 + c4;
    f32x4 v[8];
#pragma unroll
    for (int i = 0; i < 8; ++i) v[i] = __builtin_nontemporal_load((const f32x4*)(src + (size_t)(8 * i) * N));
#pragma unroll
    for (int i = 0; i < 8; ++i) { LAS float* d = scr + (8 * i + kr) * 33 + c4; d[0] = v[i].x; d[1] = v[i].y; d[2] = v[i].z; d[3] = v[i].w; }
    LDS_WAIT(); asm volatile("" ::: "memory");
    const int c = lane & 7;
#pragma unroll
    for (int j = 0; j < 4; ++j) { const int n = (lane >> 3) + 8 * j; const LAS float* s = scr + (8 * c) * 33 + n;
        v4u o; o.x = pk2(s[0 * 33], s[1 * 33]); o.y = pk2(s[2 * 33], s[3 * 33]); o.z = pk2(s[4 * 33], s[5 * 33]); o.w = pk2(s[6 * 33], s[7 * 33]);
        *(v4u*)(WT + (size_t)(n0 + n) * K + k0 + 8 * c) = o; }
    LDS_WAIT(); asm volatile("" ::: "memory");
}
template <bool PERMK = false>
__device__ __forceinline__ void transpose_item8(const float* W, int K, int N, unsigned char* WT, LAS float* scr, int item, int lane, float sc) {
    const int nblk = N / 32, kb = item / nblk, nb = item % nblk, k0 = 128 * kb, n0 = 32 * nb;
    const int kr = lane >> 3, c4 = (lane & 7) * 4;
    const float* src = W + (size_t)(k0 + kr) * N + n0 + c4;
    f32x4 v[16];
#pragma unroll
    for (int i = 0; i < 16; ++i) v[i] = __builtin_nontemporal_load((const f32x4*)(src + (size_t)(8 * i) * N));
#pragma unroll
    for (int i = 0; i < 16; ++i) { LAS float* d = scr + (8 * i + kr) * 33 + c4; d[0] = v[i].x; d[1] = v[i].y; d[2] = v[i].z; d[3] = v[i].w; }
    LDS_WAIT(); asm volatile("" ::: "memory");
    const int c = lane & 7;
#pragma unroll
    for (int j = 0; j < 4; ++j) { const int n = (lane >> 3) + 8 * j;
        if constexpr (PERMK) {
            const LAS float* s = scr + (4 * c) * 33 + n; v4u o;
#define PK_(q) pk4_fp8(s[(0 * 32 + (q)) * 33] * sc, s[(1 * 32 + (q)) * 33] * sc, s[(2 * 32 + (q)) * 33] * sc, s[(3 * 32 + (q)) * 33] * sc)
            o.x = PK_(0); o.y = PK_(1); o.z = PK_(2); o.w = PK_(3);
#undef PK_
            __builtin_nontemporal_store(o, (v4u*)(WT + (size_t)(n0 + n) * K + k0 + 16 * c)); continue; }
        const LAS float* s = scr + (16 * c) * 33 + n;
        v4u o; o.x = pk4_fp8(s[0 * 33] * sc, s[1 * 33] * sc, s[2 * 33] * sc, s[3 * 33] * sc); o.y = pk4_fp8(s[4 * 33] * sc, s[5 * 33] * sc, s[6 * 33] * sc, s[7 * 33] * sc);
        o.z = pk4_fp8(s[8 * 33] * sc, s[9 * 33] * sc, s[10 * 33] * sc, s[11 * 33] * sc); o.w = pk4_fp8(s[12 * 33] * sc, s[13 * 33] * sc, s[14 * 33] * sc, s[15 * 33] * sc);
        __builtin_nontemporal_store(o, (v4u*)(WT + (size_t)(n0 + n) * K + k0 + 16 * c)); }
    LDS_WAIT(); asm volatile("" ::: "memory");
}
__device__ __forceinline__ void rms_row_to_bf16(const float* xrow, const float* g, unsigned char* orow, int lane) {
    const f32x4* xr = (const f32x4*)xrow + lane; const f32x4* gr = (const f32x4*)g + lane;
    f32x4 v[8]; float s = 0.f;
#pragma unroll
    for (int j = 0; j < 8; ++j) { v[j] = __builtin_nontemporal_load(xr + 64 * j); s += (v[j].x * v[j].x + v[j].y * v[j].y) + (v[j].z * v[j].z + v[j].w * v[j].w); }
    const float rstd = 1.0f / sqrtf(wave_sum(s) * (1.f / DM) + EPS);
    unsigned* o8 = (unsigned*)orow + lane; const float rs = rstd * HS;
#pragma unroll
    for (int j = 0; j < 8; ++j) { const f32x4 gg = gr[64 * j]; o8[64 * j] = pk4_fp8(v[j].x * rs * gg.x, v[j].y * rs * gg.y, v[j].z * rs * gg.z, v[j].w * rs * gg.w); }
}

template <int R>
__device__ __forceinline__ void rms_rows_to_bf16(const float* x0, size_t rstride, const float* g, unsigned char* o0, size_t ostride, int lane) {
    f32x4 v[R][8]; float s[R];
#pragma unroll
    for (int r = 0; r < R; ++r) { const f32x4* xr = (const f32x4*)(x0 + r * rstride) + lane; s[r] = 0.f;
#pragma unroll
        for (int j = 0; j < 8; ++j) v[r][j] = __builtin_nontemporal_load(xr + 64 * j); }
    const f32x4* gr = (const f32x4*)g + lane;
#pragma unroll
    for (int r = 0; r < R; ++r) {
#pragma unroll
        for (int j = 0; j < 8; ++j) s[r] += (v[r][j].x * v[r][j].x + v[r][j].y * v[r][j].y) + (v[r][j].z * v[r][j].z + v[r][j].w * v[r][j].w);
        const float rstd = 1.0f / sqrtf(wave_sum(s[r]) * (1.f / DM) + EPS);
        unsigned* o8 = (unsigned*)(o0 + r * ostride) + lane; const float rs = rstd * HS;
#pragma unroll
        for (int j = 0; j < 8; ++j) { const f32x4 gg = gr[64 * j]; o8[64 * j] = pk4_fp8(v[r][j].x * rs * gg.x, v[r][j].y * rs * gg.y, v[r][j].z * rs * gg.z, v[r][j].w * rs * gg.w); } }
}

constexpr int I_GU = (DM / 128) * (DFF / 32), I_DN = (DFF / 128) * (DM / 32), NFFN_ITEMS = NE * (2 * I_GU + I_DN), NSLOT = 3;
constexpr int NGU_ITEMS = 2 * NE * I_GU, GU_SHARE = (NGU_ITEMS + NSLOT - 1) / NSLOT;
__device__ __attribute__((noinline)) void ffn_conv(const float* wg, const float* wu, const float* wd, unsigned char* WG_T, unsigned char* WU_T, unsigned char* WD_T, LAS unsigned char* L, int r0, int q, int wgi, int nwg) {
    __syncthreads();
    int tid = threadIdx.x; asm volatile("" : "+v"(tid));
    const int lane = tid & 63, wave = __builtin_amdgcn_readfirstlane(tid >> 6);
    LAS float* scr = (LAS float*)(L + wave * 16896);
    const int nw = nwg * NWAVES;
    for (int li = wgi * NWAVES + wave; li < q; li += nw) {
        int r = r0 + li;
        if (r < NE * I_GU) { const int e = r / I_GU; transpose_item8(wg + (size_t)e * DM * DFF, DM, DFF, WG_T + (size_t)e * DFF * DM, scr, r % I_GU, lane, WS); continue; } r -= NE * I_GU;
        if (r < NE * I_GU) { const int e = r / I_GU; transpose_item8(wu + (size_t)e * DM * DFF, DM, DFF, WU_T + (size_t)e * DFF * DM, scr, r % I_GU, lane, WS); continue; } r -= NE * I_GU;
        { const int e = r / I_DN; transpose_item8(wd + (size_t)e * DFF * DM, DFF, DM, WD_T + (size_t)e * DM * DFF, scr, r % I_DN, lane, WDS); }
    }
    __syncthreads();
}

struct Args { const float* in[13]; float* out; unsigned char* ws; int ph_lo, ph_hi; };

__global__ void __launch_bounds__(NWAVES * 64, 2) hymba_fwd(Args args) {
    extern __shared__ __attribute__((aligned(16))) unsigned char lds[];
    LAS unsigned char* L = (LAS unsigned char*)lds;
    volatile LAS unsigned* MISC = (volatile LAS unsigned*)(L + MISC_OFF);
    const int G = gridDim.x; const int bx = blockIdx.x; const int vcu = (G % 8 == 0) ? (bx % 8) * (G / 8) + bx / 8 : bx;
    const int NGW = G * NWAVES;
#define PH_IDS int tid = threadIdx.x; asm volatile("" : "+v"(tid)); const int lane = tid & 63, wave = __builtin_amdgcn_readfirstlane(tid >> 6), gw = vcu * NWAVES + wave; (void)lane; (void)gw;
    unsigned char* ws = args.ws;
    unsigned* ctl = (unsigned*)(ws + WS_CTL);
    for (int u = threadIdx.x; u < (LDS_BYTES - LDSCTL_OFF) / 4; u += NWAVES * 64) ((LAS unsigned*)(L + LDSCTL_OFF))[u] = 0u;
    __syncthreads();
    XcdBarrier bar; bar.bar = ctl + CW_BAR; bar.x = 0; bar.st = nullptr;
    if (!MK_SPLIT) bar = xcd_barrier_post(ctl + CW_BAR, MISC + 8);
#define GRID_BAR() do { if (!MK_SPLIT) xcd_barrier(bar); } while (0)
    const int lo = args.ph_lo, hi = args.ph_hi;
#ifdef PH_ONLY
#define IN(k) ((k) == PH_ONLY && lo <= (k) && (k) < hi)
#else
#define IN(k) (lo <= (k) && (k) < hi)
#endif
#define BOTH(k) (IN(k) && IN((k) + 1))

    const float* x = args.in[0];
    unsigned char* WIN_T = ws + WS_WIN; unsigned char* WOUT_T = ws + WS_WOUT; unsigned char* WG_T = ws + WS_WG; unsigned char* WU_T = ws + WS_WU; unsigned char* WD_T = ws + WS_WD;
    unsigned char* HN = ws + WS_HN; bf16* PROJ = (bf16*)(ws + WS_PROJ); unsigned char* ATT = ws + WS_ATT; bf16* MIX = (bf16*)(ws + WS_HN); float* RSTD = (float*)(ws + WS_RSTD); float* RS = (float*)(ws + WS_RS);
    unsigned char* Q8 = ws + WS_Q8; unsigned char* K8 = ws + WS_K8; unsigned char* VT8 = ws + WS_VT8;
    unsigned char* XG = ws + WS_XG; unsigned char* H8 = ws + WS_H8; unsigned char* ACT = ws + WS_ACT; bf16* EO = (bf16*)(ws + WS_EO);
    bf16* X1 = (bf16*)(ws + WS_PROJ);
    float* AFF = (float*)(ws + WS_AFF); int* IDX = (int*)(ws + WS_IDX); float* GATE = (float*)(ws + WS_GATE); int* SLOT = (int*)(ws + WS_SLOT);

    if (IN(0)) REP(0) {
        PH_IDS
        LAS float* scr = (LAS float*)(L + wave * 16896);
        constexpr int I_IN = (DM / 128) * (DIN / 32), I_OUT = (DM / 128) * (DM / 32);
        for (int it = gw; it < I_IN + I_OUT; it += NGW) {
            if (it < I_IN) transpose_item8<false>(args.in[2], DM, DIN, WIN_T, scr, it, lane, WIS);
            else transpose_item8<true>(args.in[6], DM, DM, WOUT_T, scr, it - I_IN, lane, WIS);
        }
        { int m = gw;
          for (; m + 3 * NGW < T; m += 4 * NGW) rms_rows_to_bf16<4>(x + (size_t)m * DM, (size_t)NGW * DM, args.in[1], HN + (size_t)m * DM, (size_t)NGW * DM, lane);
          for (; m < T; m += NGW) rms_row_to_bf16(x + (size_t)m * DM, args.in[1], HN + (size_t)m * DM, lane); }
        if (BOTH(0)) GRID_BAR();
    }

    if (IN(1)) REP(1) {
        pg8::Gemm g{(const pg8::bf16_t*)HN, (const pg8::bf16_t*)WIN_T, DM / 2, T / 256, DIN / 256, (size_t)32 * DM, (size_t)256 * DM, 0, nullptr, nullptr};
        pg8::StaticOrder S; S.WGM = WGM_P1; S.init(T / 256, DIN / 256, G, bx);
        LAS float* rtab = (LAS float*)(L + RING_BYTES + 4096);
        for (int idx = threadIdx.x; idx < 64 * 32; idx += NWAVES * 64) { float a = (float)(idx >> 5) * __builtin_amdgcn_exp2f(-(float)(idx & 31) * (13.287712379549449f / 32.0f)) * 0.15915494309189535f; a -= floorf(a);
            rtab[2 * idx] = __builtin_amdgcn_cosf(a); rtab[2 * idx + 1] = __builtin_amdgcn_sinf(a); }
        __syncthreads();
        pg8::EpiProj E{PROJ, DIN, args.in[4], args.in[5], (LAS float*)(L + RING_BYTES), rtab, 1.0f / (HS * WIS), Q8, K8, VT8};
        pg8::gemm_phase<pg8::EpiProj, pg8::StaticOrder, true, true, true>(L, g, S, E);
        if (BOTH(1)) GRID_BAR();
    }


    if (IN(3)) REP(3) {
        const int slot = vcu % NSLOT; int seq = 0; bool conv_done = false;
#define FFN_CONV() do { const int r0_ = slot * GU_SHARE, q_ = (NGU_ITEMS - r0_) < GU_SHARE ? (NGU_ITEMS - r0_) : GU_SHARE; \
            ffn_conv(args.in[9], args.in[10], args.in[11], WG_T, WU_T, WD_T, L, r0_, q_, vcu / NSLOT, (G - slot + NSLOT - 1) / NSLOT); conv_done = true; } while (0)
        for (int U = vcu; U < 512; U += G, ++seq) {
            if (slot == seq && !conv_done) FFN_CONV();
            const int combo = (U >> 5) & 7, j = (U >> 8) * 32 + (U & 31);
            const int b = combo >> 1, kvh = combo & 1, h = kvh * 4 + (j >> 4), qb = j & 15, q0 = qb * 256;
            const size_t rowb = (size_t)b * SEQ;
            att::attn_body8<ATT_SD_B>(Q8 + (rowb + q0) * 1024 + h * HD, K8 + rowb * 256 + kvh * HD, VT8 + (size_t)(b * 2 + kvh) * HD * SEQ,
                                  ATT + (rowb + q0) * DM + 1024 + h * HD, SEQ / 64, (char*)lds);
        }
        if (slot <= 2 && !conv_done) FFN_CONV();
        for (int U = vcu; U < 512; U += G) {
            const int combo = (U >> 5) & 7, j = (U >> 8) * 32 + (U & 31);
            const int b = combo >> 1, kvh = combo & 1, h = kvh * 4 + (j >> 4), qb = j & 15, q0 = qb * 256;
            const size_t rowb = (size_t)b * SEQ;
            const int klo = q0 >= 128 ? q0 - 128 : 0, khi = (q0 + 384 <= SEQ) ? q0 + 384 : SEQ;
            att::attn_body<true, ATT_SD_A>(PROJ + (rowb + q0) * DIN + COL_QA + h * HD, PROJ + (rowb + klo) * DIN + COL_KA + kvh * HD,
                                 ATT + (rowb + q0) * DM + h * HD, (khi - klo) / 64, (char*)lds, q0 - klo, __builtin_amdgcn_exp2f(-(float)(h + 1)), args.in[3][h]);
        }
        if (!conv_done) FFN_CONV();
#undef FFN_CONV
        if (BOTH(3)) GRID_BAR();
    }

    if (IN(4)) REP(4) {
        pg8::Gemm g{(const pg8::bf16_t*)ATT, (const pg8::bf16_t*)WOUT_T, DM / 2, T / 256, DM / 256, (size_t)128 * DM, (size_t)256 * DM, 0, nullptr, nullptr};
        pg8::StaticOrder S; S.WGM = WGM_P4; S.init(T / 256, DM / 256, G, bx);
        pg8::EpiBf16 E{MIX, DM, 1.0f / (OS * WIS)};
        pg8::gemm_phase<pg8::EpiBf16, pg8::StaticOrder, true, true, true>(L, g, S, E);
        if (BOTH(4)) GRID_BAR();
    }

    if (IN(5)) REP(5) {
        PH_IDS
        constexpr int WST = DM + 4;
        LAS float* wT = (LAS float*)L; LAS float* gL = (LAS float*)(L + NE * WST * 4); LAS float* comb = (LAS float*)(L + NE * WST * 4 + DM * 4);
        static_assert(NE * WST * 4 + DM * 4 + 4 * 64 * 5 * 4 <= LDSCTL_OFF, "P5 LDS map");
        for (int idx = tid; idx < NE * DM; idx += NWAVES * 64) { const int e = idx & 15, d = idx >> 4; wT[e * WST + d] = args.in[8][idx] * args.in[7][d]; }
        for (int d = tid; d < DM; d += NWAVES * 64) gL[d] = args.in[7][d];
        __syncthreads();
        const int j = lane & 15, kq = lane >> 4, gi = wave & 3, kh = wave >> 2;
        for (int base = vcu * 4; base < T / 16; base += G * 4) {
            asm volatile("" ::: "memory");
            const int t0 = (base + gi) * 16;
            const size_t rowoff = (size_t)(t0 + j) * DM + kh * 1024 + 8 * kq;
            const float* xp = x + rowoff; const bf16* mp = MIX + rowoff; unsigned char* hp = H8 + rowoff; bf16* x1p = X1 + rowoff;
            const LAS float* wp = wT + j * WST + kh * 1024 + 8 * kq; const LAS float* gp = gL + kh * 1024 + 8 * kq;
            f32x4 acc = {0.f, 0.f, 0.f, 0.f}; float ss = 0.f;
            f32x4 xa[2][4], xb[2][4]; v4u mm[2][4];
#define P5_LOAD(bf, bt) do { _Pragma("unroll") for (int u = 0; u < 4; ++u) { const int m = (bt) * 4 + u; xa[bf][u] = *(const f32x4*)(xp + 32 * m); xb[bf][u] = *(const f32x4*)(xp + 32 * m + 4); mm[bf][u] = *(const v4u*)(mp + 32 * m); } } while (0)
#define P5_COMP(bf, bt) do { _Pragma("unroll") for (int u = 0; u < 4; ++u) { const int m = (bt) * 4 + u; \
                const f32x4 wa = *(const LAS f32x4*)(wp + 32 * m), wb = *(const LAS f32x4*)(wp + 32 * m + 4), ga = *(const LAS f32x4*)(gp + 32 * m), gb = *(const LAS f32x4*)(gp + 32 * m + 4); \
                f32x4 a = xa[bf][u], b = xb[bf][u]; const v4u q = mm[bf][u]; \
                a.x += bf_lo(q.x); a.y += bf_hi(q.x); a.z += bf_lo(q.y); a.w += bf_hi(q.y); b.x += bf_lo(q.z); b.y += bf_hi(q.z); b.z += bf_lo(q.w); b.w += bf_hi(q.w); \
                acc = __builtin_amdgcn_mfma_f32_16x16x4f32(wa.x, a.x, acc, 0, 0, 0); acc = __builtin_amdgcn_mfma_f32_16x16x4f32(wa.y, a.y, acc, 0, 0, 0); \
                acc = __builtin_amdgcn_mfma_f32_16x16x4f32(wa.z, a.z, acc, 0, 0, 0); acc = __builtin_amdgcn_mfma_f32_16x16x4f32(wa.w, a.w, acc, 0, 0, 0); \
                acc = __builtin_amdgcn_mfma_f32_16x16x4f32(wb.x, b.x, acc, 0, 0, 0); acc = __builtin_amdgcn_mfma_f32_16x16x4f32(wb.y, b.y, acc, 0, 0, 0); \
                acc = __builtin_amdgcn_mfma_f32_16x16x4f32(wb.z, b.z, acc, 0, 0, 0); acc = __builtin_amdgcn_mfma_f32_16x16x4f32(wb.w, b.w, acc, 0, 0, 0); \
                ss += (a.x * a.x + a.y * a.y) + (a.z * a.z + a.w * a.w) + (b.x * b.x + b.y * b.y) + (b.z * b.z + b.w * b.w); \
                v2u o; o.x = pk4_fp8(a.x * ga.x * XS, a.y * ga.y * XS, a.z * ga.z * XS, a.w * ga.w * XS); o.y = pk4_fp8(b.x * gb.x * XS, b.y * gb.y * XS, b.z * gb.z * XS, b.w * gb.w * XS); \
                *(v2u*)(hp + 32 * m) = o; \
                v4u o1; o1.x = cvt_pk_bf16(a.x, a.y); o1.y = cvt_pk_bf16(a.z, a.w); o1.z = cvt_pk_bf16(b.x, b.y); o1.w = cvt_pk_bf16(b.z, b.w); *(v4u*)(x1p + 32 * m) = o1; } } while (0)
            P5_LOAD(0, 0);
#pragma unroll
            for (int bt = 0; bt < 8; bt += 2) {
                P5_LOAD(1, bt + 1);
                P5_COMP(0, bt);
                if (bt + 2 < 8) P5_LOAD(0, bt + 2);
                P5_COMP(1, bt + 1);
            }
#undef P5_LOAD
#undef P5_COMP
            LAS float* cb = comb + (gi * 64 + lane) * 5;
            if (kh == 1) { cb[0] = acc[0]; cb[1] = acc[1]; cb[2] = acc[2]; cb[3] = acc[3]; cb[4] = ss; }
            __syncthreads();
            if (kh == 0) {
                acc[0] += cb[0]; acc[1] += cb[1]; acc[2] += cb[2]; acc[3] += cb[3]; ss += cb[4];
                ss += __shfl_xor(ss, 16); ss += __shfl_xor(ss, 32);
                const float rstd = 1.0f / sqrtf(ss * (1.f / DM) + EPS);
                float l0 = acc[0] * rstd, l1 = acc[1] * rstd, l2 = acc[2] * rstd, l3 = acc[3] * rstd;
                float mx = fmaxf(fmaxf(l0, l1), fmaxf(l2, l3)); mx = fmaxf(mx, __shfl_xor(mx, 16)); mx = fmaxf(mx, __shfl_xor(mx, 32));
                l0 = __expf(l0 - mx); l1 = __expf(l1 - mx); l2 = __expf(l2 - mx); l3 = __expf(l3 - mx);
                float den = (l0 + l1) + (l2 + l3); den += __shfl_xor(den, 16); den += __shfl_xor(den, 32);
                const float rden = 1.0f / den;
                float* ap = AFF + ((size_t)(t0 >> 12) * NE + 4 * kq) * SEQ + (t0 & (SEQ - 1)) + j;
                ap[0] = l0 * rden; ap[SEQ] = l1 * rden; ap[2 * SEQ] = l2 * rden; ap[3 * SEQ] = l3 * rden;
                if (kq == 0) RSTD[t0 + j] = rstd;
            }
            __syncthreads();
        }
        if (BOTH(5)) GRID_BAR();
    }

    if (IN(6)) REP(6) {
        PH_IDS
        LAS unsigned* red = (LAS unsigned*)L;
        for (int be = vcu; be < BATCH * NE; be += G) {
            const int b = be / NE, e = be % NE;
            const float* a = AFF + (size_t)be * SEQ + tid * 8;
            const f32x4 a0 = *(const f32x4*)a, a1 = *(const f32x4*)(a + 4);
            float av[8] = {a0.x, a0.y, a0.z, a0.w, a1.x, a1.y, a1.z, a1.w};
            unsigned key[8];
#pragma unroll
            for (int i = 0; i < 8; ++i) key[i] = __float_as_uint(av[i]);
            unsigned prefix = 0u;
            for (int bit = 30; bit >= 0; --bit) {
                const unsigned cand = prefix | (1u << bit);
                unsigned c = 0u;
#pragma unroll
                for (int i = 0; i < 8; ++i) c += (unsigned)__builtin_popcountll(__ballot(key[i] >= cand));
                LAS unsigned* slot = red + (bit & 1) * 8;
                if (lane == 0) slot[wave] = c;
                __syncthreads();
                unsigned tot = 0u;
#pragma unroll
                for (int w = 0; w < 8; ++w) tot += slot[w];
                if (tot >= (unsigned)CAP) prefix = cand;
            }
            __syncthreads();
            unsigned cgt = 0u, ceq = 0u;
#pragma unroll
            for (int i = 0; i < 8; ++i) { cgt += (key[i] > prefix) ? 1u : 0u; ceq += (key[i] == prefix) ? 1u : 0u; }
            unsigned pk = cgt | (ceq << 16), incl = pk;
#pragma unroll
            for (int o = 1; o < 64; o <<= 1) { const unsigned n = __shfl_up(incl, o); if (lane >= o) incl += n; }
            LAS unsigned* wtot = red + 64;
            if (lane == 63) wtot[wave] = incl;
            __syncthreads();
            unsigned woff = 0u, total = 0u;
#pragma unroll
            for (int w = 0; w < 8; ++w) { const unsigned v = wtot[w]; if (w < wave) woff += v; total += v; }
            const unsigned excl = woff + incl - pk;
            const unsigned need_eq = (unsigned)CAP - (total & 0xffffu);
            unsigned gt_before = excl & 0xffffu, eq_before = excl >> 16;
            const int mbase = (e * BATCH + b) * CAP;
#pragma unroll
            for (int i = 0; i < 8; ++i) {
                const int tok = tid * 8 + i;
                const bool isgt = key[i] > prefix, iseq = key[i] == prefix;
                const bool sel = isgt || (iseq && eq_before < need_eq);
                const unsigned slot = gt_before + (eq_before < need_eq ? eq_before : need_eq);
                if (sel) { IDX[mbase + slot] = tok; GATE[mbase + slot] = av[i]; RS[mbase + slot] = RSTD[(size_t)b * SEQ + tok]; }
                SLOT[((size_t)b * SEQ + tok) * NE + e] = sel ? (int)slot : -1;
                gt_before += isgt ? 1u : 0u; eq_before += iseq ? 1u : 0u;
            }
            __syncthreads();
        }
        if (BOTH(6)) GRID_BAR();
    }


    if (IN(8)) REP(8) {
        pg8::Gemm g{(const bf16*)H8, (const bf16*)WG_T, DM / 2, MS / 256, DFF / 128, (size_t)(WS_WU - WS_WG), (size_t)128 * DM, (size_t)DFF * DM, IDX, (LAS int*)(L + RING_BYTES + 20480)};
        pg8::StaticOrder S; S.WGM = WGM_P8; S.init(MS / 256, DFF / 128, G, bx);
        pg8::EpiSwiGlu8 E{ACT, DFF, 1.0f / (XS * WS), AS, RS};
        const int nmine = (MS / 256 * (DFF / 128) - bx + G - 1) / G, split = nmine > 0 ? vcu % nmine : 0;
        for (int part = 0; part < 2; ++part) {
            S.i0 = part ? split : 0; S.ni = part ? (1 << 30) : split;
            pg8::gemm_phase<pg8::EpiSwiGlu8, pg8::StaticOrder, true, true, true, true>(L, g, S, E);
            if (part == 0) ffn_conv(args.in[9], args.in[10], args.in[11], WG_T, WU_T, WD_T, L, NGU_ITEMS, NFFN_ITEMS - NGU_ITEMS, vcu, G);
        }
        if (BOTH(8)) GRID_BAR();
    }

    if (IN(9)) REP(9) {
        pg8::Gemm g{(const bf16*)ACT, (const bf16*)WD_T, DFF / 2, MS / 256, DM / 256, (size_t)128 * DFF, (size_t)256 * DFF, (size_t)DM * DFF, nullptr, nullptr};
        pg8::StaticOrder S; S.WGM = WGM_P9; S.init(MS / 256, DM / 256, G, bx);
        pg8::EpiBf16 E{EO, DM, 1.0f / (AS * WDS)};
        pg8::gemm_phase<pg8::EpiBf16, pg8::StaticOrder, true, true, true>(L, g, S, E);
        if (BOTH(9)) GRID_BAR();
    }

    if (IN(10)) REP(10) {
        PH_IDS
        const unsigned bad = __hip_atomic_load(ctl + CW_BAR + XB_TMO, RLX_AGENT);
        f32x4 gg[8];
#pragma unroll
        for (int j = 0; j < 8; ++j) gg[j] = ((const f32x4*)args.in[12])[lane + 64 * j];
        for (int t = gw; t < T; t += NGW) {
            const v2u* mr = (const v2u*)(X1 + (size_t)t * DM) + lane;
            f32x4 v[8];
#pragma unroll
            for (int j = 0; j < 8; ++j) { const v2u w = __builtin_nontemporal_load(mr + 64 * j); v[j].x = bf_lo(w.x); v[j].y = bf_hi(w.x); v[j].z = bf_lo(w.y); v[j].w = bf_hi(w.y); }
            const int myslot = SLOT[(size_t)t * NE + (lane & 15)];
            const int b = t >> 12;
            for (int e = 0; e < NE; ++e) {
                const int sl = __builtin_amdgcn_readlane(myslot, e);
                if (sl >= 0) {
                    const int m = (e * BATCH + b) * CAP + sl; const float gt = GATE[m];
                    const v2u* er = (const v2u*)(EO + (size_t)m * DM) + lane;
#pragma unroll
                    for (int j = 0; j < 8; ++j) { const v2u w = __builtin_nontemporal_load(er + 64 * j); v[j].x += gt * bf_lo(w.x); v[j].y += gt * bf_hi(w.x); v[j].z += gt * bf_lo(w.y); v[j].w += gt * bf_hi(w.y); }
                }
            }
            float s = 0.f;
#pragma unroll
            for (int j = 0; j < 8; ++j) s += (v[j].x * v[j].x + v[j].y * v[j].y) + (v[j].z * v[j].z + v[j].w * v[j].w);
            const float rstd = bad ? __builtin_nanf("") : 1.0f / sqrtf(wave_sum(s) * (1.f / DM) + EPS);
            f32x4* orow = (f32x4*)(args.out + (size_t)t * DM) + lane;
#pragma unroll
            for (int j = 0; j < 8; ++j) __builtin_nontemporal_store(v[j] * rstd * gg[j], orow + 64 * j);
        }
    }
#undef PH_IDS
#undef IN
#undef BOTH
#undef GRID_BAR
}

extern "C" void kernel_launch(void* const* d_in, const int* in_sizes, int n_in, void* d_out, int out_size, void* d_ws, size_t ws_size, hipStream_t stream) {
    static int grid = 0;
    if (grid == 0) {
        if (n_in != 13 || in_sizes[0] != T * DM || out_size != T * DM || ws_size < WS_END) {
            fprintf(stderr, "kernel_launch: shape mismatch: n_in %d in0 %d out %d ws %zu (need >= %zu)\n", n_in, n_in > 0 ? in_sizes[0] : -1, out_size, ws_size, (size_t)WS_END); grid = -1; return; }
        int dev = 0, cus = 0;
        if (hipGetDevice(&dev) != hipSuccess || hipDeviceGetAttribute(&cus, hipDeviceAttributeMultiprocessorCount, dev) != hipSuccess) { grid = -1; return; }
        if (hipFuncSetAttribute((const void*)hymba_fwd, hipFuncAttributeMaxDynamicSharedMemorySize, LDS_BYTES) != hipSuccess) { fprintf(stderr, "kernel_launch: hipFuncSetAttribute failed\n"); grid = -1; return; }
        int per_cu = 0;
        if (hipOccupancyMaxActiveBlocksPerMultiprocessor(&per_cu, (const void*)hymba_fwd, NWAVES * 64, LDS_BYTES) != hipSuccess || per_cu < 1)
            fprintf(stderr, "kernel_launch: note: occupancy query reports %d workgroups per CU\n", per_cu);
        (void)hipGetLastError();
        grid = cus;
    }
    if (grid < 0) return;
    if (hipMemsetAsync((char*)d_ws + WS_CTL, 0, CTL_ZERO_BYTES, stream) != hipSuccess) { fprintf(stderr, "kernel_launch: memset failed\n"); return; }
    Args a{};
    for (int i = 0; i < 13; ++i) a.in[i] = (const float*)d_in[i];
    a.out = (float*)d_out; a.ws = (unsigned char*)d_ws;
#if MK_SPLIT
    for (int p = 0; p < NPHASE; ++p) { a.ph_lo = p; a.ph_hi = p + 1; hipLaunchKernelGGL(hymba_fwd, dim3(grid), dim3(NWAVES * 64), LDS_BYTES, stream, a); }
#else
    a.ph_lo = 0; a.ph_hi = NPHASE;
    hipLaunchKernelGGL(hymba_fwd, dim3(grid), dim3(NWAVES * 64), LDS_BYTES, stream, a);
#endif
    const hipError_t le = hipPeekAtLastError();
    if (le != hipSuccess) fprintf(stderr, "kernel_launch: launch failed: %s\n", hipGetErrorName(le));
}
```

```cpp
#include <hip/hip_runtime.h>
#include <cstdio>
#include <cstdint>

#ifndef ATT_SD_B
#define ATT_SD_B 2
#endif
#ifndef ATT_SD_A
#define ATT_SD_A 1
#endif
#ifndef DUP_MASK
#define DUP_MASK 0
#endif
#define REP(k) for (int _r = 0; _r < (((DUP_MASK >> (k)) & 1) ? 2 : 1); ++_r)
#ifndef WGM_P1
#define WGM_P1 4
#endif
#ifndef WGM_P4
#define WGM_P4 4
#endif
#ifndef WGM_P8
#define WGM_P8 4
#endif
#ifndef WGM_P9
#define WGM_P9 4
#endif
#ifndef MK_SPLIT
#define MK_SPLIT 0
#endif

constexpr int BATCH = 4, SEQ = 4096, DM = 2048, T = BATCH * SEQ, DIN = 3072, HD = 128;
constexpr int NE = 16, CAP = 512, DFF = 4096, MS = BATCH * NE * CAP;
constexpr float EPS = 1e-6f;
constexpr int COL_QA = 0, COL_KA = 1024, COL_VA = 1280, COL_QB = 1536, COL_KB = 2560, COL_VB = 2816;
constexpr int NPHASE = 11;
constexpr float QSQ = 0.088388347648318440f * 1.4426950408889634f * 2048.f / 16.f;
constexpr float QS = 16.f, PSC = 8.f;
constexpr float HS = 16.f, WIS = 1024.f, OS = 32.f;
constexpr float XS = 16.f, WS = 1024.f, AS = 16.f, WDS = 2048.f;
static_assert(COL_VA - COL_KA == 256 && COL_VB - COL_KB == 256, "V sits 256 columns right of K");

constexpr size_t MiB = 1u << 20;
constexpr size_t WS_CTL = 0, CTL_ZERO_BYTES = 1 * MiB;
constexpr size_t WS_AFF = 1 * MiB;
constexpr size_t WS_IDX = 2 * MiB;
constexpr size_t WS_GATE = 3 * MiB;
constexpr size_t WS_SLOT = 4 * MiB;
constexpr size_t WS_RSTD = 5 * MiB;
constexpr size_t WS_RS = 6 * MiB;
constexpr size_t WS_ROPE = 7 * MiB;
constexpr size_t WS_WIN = 8 * MiB;
constexpr size_t WS_WOUT = 20 * MiB;
constexpr size_t WS_HN = 32 * MiB;
constexpr size_t WS_PROJ = 96 * MiB;
constexpr size_t WS_ATT = 192 * MiB;
constexpr size_t WS_Q8 = 256 * MiB;
constexpr size_t WS_K8 = 272 * MiB;
constexpr size_t WS_VT8 = 280 * MiB;
constexpr size_t WS_WG = 384 * MiB;
constexpr size_t WS_WU = 640 * MiB;
constexpr size_t WS_WD = 896 * MiB;
constexpr size_t WS_XG = 1152 * MiB;
constexpr size_t WS_H8 = 1216 * MiB;
constexpr size_t WS_ACT = 1280 * MiB;
constexpr size_t WS_EO = 1536 * MiB;
constexpr size_t WS_END = 1664 * MiB;
constexpr int CW_TMO = 0, CW_BAR = 4096;

constexpr int RING_BYTES = 131072;
constexpr int LDSCTL_OFF = 161792, MISC_OFF = LDSCTL_OFF + 320;
constexpr int LDS_BYTES = 163840;
constexpr int NWAVES = 8;

#define GAS __attribute__((address_space(1)))
#define LAS __attribute__((address_space(3)))
typedef unsigned short bf16;
typedef unsigned v4u __attribute__((ext_vector_type(4)));
typedef unsigned v2u __attribute__((ext_vector_type(2)));
typedef float f32x4 __attribute__((ext_vector_type(4)));
typedef GAS unsigned gu32;
#define RLX_AGENT __ATOMIC_RELAXED, __HIP_MEMORY_SCOPE_AGENT
#define LDS_WAIT() asm volatile("s_waitcnt lgkmcnt(0)" ::: "memory")
#define VM_WAIT() asm volatile("s_waitcnt vmcnt(0)" ::: "memory")
__device__ __forceinline__ unsigned cvt_pk_bf16(float lo, float hi) { unsigned r; asm volatile("v_cvt_pk_bf16_f32 %0, %1, %2" : "=v"(r) : "v"(lo), "v"(hi)); return r; }
__device__ __forceinline__ float clamp8(float v) { return __builtin_amdgcn_fmed3f(v, -448.f, 448.f); }
__device__ __forceinline__ unsigned pk4_fp8(float a, float b, float c, float d) {
    int w = 0; w = __builtin_amdgcn_cvt_pk_fp8_f32(clamp8(a), clamp8(b), w, false); w = __builtin_amdgcn_cvt_pk_fp8_f32(clamp8(c), clamp8(d), w, true); return (unsigned)w; }
__device__ __forceinline__ unsigned pk4_fp8_nc(float a, float b, float c, float d) { int w = 0; w = __builtin_amdgcn_cvt_pk_fp8_f32(a, b, w, false); w = __builtin_amdgcn_cvt_pk_fp8_f32(c, d, w, true); return (unsigned)w; }
__device__ __forceinline__ float bf_lo(unsigned w) { return __uint_as_float(w << 16); }
__device__ __forceinline__ float bf_hi(unsigned w) { return __uint_as_float(w & 0xffff0000u); }
__device__ __forceinline__ float wave_sum(float v) {
#pragma unroll
    for (int o = 1; o < 64; o <<= 1) v += __shfl_xor(v, o);
    return v;
}

namespace pg8 {
#define PG8_LAS __attribute__((address_space(3)))
typedef unsigned short bf16_t;
typedef short bf16x8 __attribute__((ext_vector_type(8)));
typedef float f32x4 __attribute__((ext_vector_type(4)));
typedef unsigned u32x4 __attribute__((ext_vector_type(4)));
typedef unsigned u32x2 __attribute__((ext_vector_type(2)));
typedef int i32x4 __attribute__((ext_vector_type(4)));
typedef int i32x8 __attribute__((ext_vector_type(8)));
constexpr int BM = 256, BK = 64, HALF = 128, HTB = HALF * BK * 2, STAGE_BYTES = 8 * HTB, NXCD = 8;

__host__ __device__ __forceinline__ int lds_byte(int r, int c) { const int st = (r >> 4) * 2 + (c >> 5), rr = r & 15, cc = c & 31, ob = rr * 64 + cc * 2; return st * 1024 + (ob ^ (((ob >> 9) & 1) << 5)); }
__host__ __device__ __forceinline__ void stage_rc(int b, int& R, int& C) { const int st = b / 1024, sb = b % 1024, swz = sb ^ (((sb >> 9) & 1) << 5); R = (st >> 1) * 16 + swz / 64; C = (st & 1) * 32 + (swz % 64) / 2; }
__host__ __device__ __forceinline__ int perm32(int rho) { const int n = rho >> 4, i = rho & 15; return 8 * (i >> 2) + 4 * n + (i & 3); }

struct Unit { int pm, pn; };
struct Gemm { const bf16_t* A; const bf16_t* Bt; int K, nM, nN; size_t bh, bt, be; const int* gidx; PG8_LAS int* gtab; };

struct StaticOrder {
    int nM, nN, nwg, G, c, i0 = 0, ni = 1 << 30, WGM = 4;
    __host__ __device__ void init(int nM_, int nN_, int G_, int c_) { nM = nM_; nN = nN_; nwg = nM * nN; G = G_; c = c_; }
    __host__ __device__ bool next(int i, Unit& u) const {
        if (i >= ni) return false;
        const long L = (long)(i + i0) * G + c; if (L >= nwg) return false;
        int wgid = (int)L; { const int q = nwg / NXCD, r = nwg % NXCD, xcd = wgid % NXCD, off = wgid / NXCD; wgid = (xcd < r ? xcd * (q + 1) : r * (q + 1) + (xcd - r) * q) + off; }
        const int nig = WGM * nN, gid = wgid / nig, fm = gid * WGM, gsz = (nM - fm) < WGM ? (nM - fm) : WGM;
        u.pm = fm + ((wgid % nig) % gsz); u.pn = (wgid % nig) / gsz; return true;
    }
    __device__ __forceinline__ void a_ready(const Unit&) const {}
    __device__ __forceinline__ void done(const Unit&) const {}
};

struct EpiBf16 {
    static constexpr bool PERM = true, HEADSPLIT = false, HAS_PRE = false;
    bf16_t* O; int ldc; float sc;
    __device__ __forceinline__ void operator()(const f32x4 (&acc)[2][2][4][2], const Unit& u, int wr, int wc, int fr, int fq) const {
        const int row0 = u.pm * BM + wr * 64 + fr, col0 = u.pn * BM + wc * 32 + 8 * fq;
#pragma unroll
        for (int ai = 0; ai < 2; ++ai)
#pragma unroll
            for (int m = 0; m < 4; ++m) { bf16_t* rowp = O + (size_t)(row0 + ai * HALF + m * 16) * ldc + col0;
#pragma unroll
                for (int bj = 0; bj < 2; ++bj) { const f32x4 v0 = acc[ai][bj][m][0] * sc, v1 = acc[ai][bj][m][1] * sc;
                    u32x4 w; w.x = cvt_pk_bf16(v0[0], v0[1]); w.y = cvt_pk_bf16(v0[2], v0[3]); w.z = cvt_pk_bf16(v1[0], v1[1]); w.w = cvt_pk_bf16(v1[2], v1[3]);
                    *(u32x4*)(rowp + bj * HALF) = w; } }
    }
};
typedef _Float16 h2 __attribute__((ext_vector_type(2)));
struct EpiProj {
    static constexpr bool PERM = true, HEADSPLIT = true, HAS_PRE = false;
    bf16_t* O; int ldc; const float* gq; const float* gk; PG8_LAS float* xch; const PG8_LAS float* ropetab;
    float sc;
    unsigned char* Q8; unsigned char* K8; unsigned char* VT8;
    __device__ __forceinline__ void operator()(const f32x4 (&acc)[2][2][4][2], const Unit& u, int wr, int wc, int fr, int fq) const {
        const int row0 = u.pm * BM + wr * 64 + fr, col0 = u.pn * BM + 128 * (wc >> 1) + 64 * (wc & 1) + 8 * fq;
        const bool rope = u.pn >= COL_QB / BM && u.pn < COL_VB / BM;
        if (u.pn == COL_VB / BM) {
            unsigned char* vbase = VT8 + ((size_t)(((u.pm >> 4) * 2 + (wc >> 1)) * HD + 64 * (wc & 1))) * SEQ;
            const unsigned loff = (unsigned)(8 * fq) * SEQ + (unsigned)((u.pm & 15) * BM + wr * 64 + fr);
#pragma unroll
            for (int ai = 0; ai < 2; ++ai)
#pragma unroll
                for (int m = 0; m < 4; ++m) {
#pragma unroll
                    for (int bj = 0; bj < 2; ++bj)
#pragma unroll
                        for (int n = 0; n < 2; ++n) { const f32x4 x = acc[ai][bj][m][n] * (QS * sc); const unsigned w = pk4_fp8(x[0], x[1], x[2], x[3]);
#pragma unroll
                            for (int e = 0; e < 4; ++e) vbase[(size_t)(32 * bj + 4 * n + e) * SEQ + (loff + (unsigned)(ai * HALF + m * 16))] = (unsigned char)(w >> (8 * e)); }
                    asm volatile("" ::: "memory"); }
            return;
        }
        if (!rope) {
#pragma unroll
            for (int ai = 0; ai < 2; ++ai)
#pragma unroll
                for (int m = 0; m < 4; ++m) { bf16_t* rowp = O + (size_t)(row0 + ai * HALF + m * 16) * ldc + col0;
#pragma unroll
                    for (int bj = 0; bj < 2; ++bj) { const f32x4 v0 = acc[ai][bj][m][0] * sc, v1 = acc[ai][bj][m][1] * sc;
                        u32x4 w; w.x = cvt_pk_bf16(v0[0], v0[1]); w.y = cvt_pk_bf16(v0[2], v0[3]); w.z = cvt_pk_bf16(v1[0], v1[1]); w.w = cvt_pk_bf16(v1[2], v1[3]);
                        *(u32x4*)(rowp + bj * 32) = w; } }
            return;
        }
        const int half = wc & 1;
        float ssq[2][4];
#pragma unroll
        for (int ai = 0; ai < 2; ++ai)
#pragma unroll
            for (int m = 0; m < 4; ++m) { float q = 0.f;
#pragma unroll
                for (int bj = 0; bj < 2; ++bj)
#pragma unroll
                    for (int n = 0; n < 2; ++n) { const f32x4 x = acc[ai][bj][m][n]; q += (x[0] * x[0] + x[1] * x[1]) + (x[2] * x[2] + x[3] * x[3]); }
                q += __shfl_xor(q, 16); q += __shfl_xor(q, 32); ssq[ai][m] = q;
                if (fq == 0) xch[(ai * HALF + wr * 64 + m * 16 + fr) * 4 + wc] = q; }
        asm volatile("s_waitcnt lgkmcnt(0)" ::: "memory"); __builtin_amdgcn_s_barrier(); asm volatile("" ::: "memory");
        const float* g = (u.pn >= COL_KB / BM) ? gk : gq;
        const f32x4 g1a = *(const f32x4*)(g + 64 * half + 8 * fq), g1b = *(const f32x4*)(g + 64 * half + 8 * fq + 4), g2a = *(const f32x4*)(g + 64 * half + 32 + 8 * fq), g2b = *(const f32x4*)(g + 64 * half + 32 + 8 * fq + 4);
#pragma unroll
        for (int ai = 0; ai < 2; ++ai)
#pragma unroll
            for (int m = 0; m < 4; ++m) {
                const int rl = ai * HALF + wr * 64 + m * 16 + fr, row = u.pm * BM + rl, srow = row & (SEQ - 1);
                const float tot = ssq[ai][m] + xch[rl * 4 + (wc ^ 1)];
                const float rstd = sc / sqrtf(tot * (sc * sc * (1.f / HD)) + EPS);
                const int pos = half ? (srow & 63) : (srow >> 6);
                const PG8_LAS f32x4* tb = (const PG8_LAS f32x4*)(ropetab + (pos * 32 + 8 * fq) * 2);
                f32x4 o1[2], o2[2];
#pragma unroll
                for (int n = 0; n < 2; ++n) { const f32x4 ga = n ? g1b : g1a, gb = n ? g2b : g2a; const f32x4 t0 = tb[2 * n], t1 = tb[2 * n + 1];
#pragma unroll
                    for (int e = 0; e < 4; ++e) { const float cs = (e < 2 ? t0 : t1)[2 * (e & 1)], sn = (e < 2 ? t0 : t1)[2 * (e & 1) + 1];
                        const float y1 = acc[ai][0][m][n][e] * rstd * ga[e], y2 = acc[ai][1][m][n][e] * rstd * gb[e];
                        o1[n][e] = y1 * cs - y2 * sn; o2[n][e] = y2 * cs + y1 * sn; } }
                unsigned char* rowp = (u.pn >= COL_KB / BM) ? K8 + (size_t)row * 256 + 128 * (wc >> 1) + 64 * half + 8 * fq
                                                            : Q8 + (size_t)row * 1024 + 128 * ((u.pn - COL_QB / BM) * 2 + (wc >> 1)) + 64 * half + 8 * fq;
                const float qs = (u.pn >= COL_KB / BM) ? QS : QSQ;
                u32x2 w; w.x = pk4_fp8(o1[0][0] * qs, o1[0][1] * qs, o1[0][2] * qs, o1[0][3] * qs); w.y = pk4_fp8(o1[1][0] * qs, o1[1][1] * qs, o1[1][2] * qs, o1[1][3] * qs);
                *(u32x2*)rowp = w;
                w.x = pk4_fp8(o2[0][0] * qs, o2[0][1] * qs, o2[0][2] * qs, o2[0][3] * qs); w.y = pk4_fp8(o2[1][0] * qs, o2[1][1] * qs, o2[1][2] * qs, o2[1][3] * qs);
                *(u32x2*)(rowp + 32) = w; }
    }
};
struct EpiResF32 {
    static constexpr bool PERM = false, HEADSPLIT = false, HAS_PRE = false;
    const float* base; float* C; int ldc;
    __device__ __forceinline__ void operator()(const f32x4 (&acc)[2][2][4][2], const Unit& u, int wr, int wc, int fr, int fq) const {
        const int row0 = u.pm * BM + wr * 64 + fr, col0 = u.pn * BM + wc * 32 + 4 * fq;
#pragma unroll
        for (int ai = 0; ai < 2; ++ai)
#pragma unroll
            for (int m = 0; m < 4; ++m) { const size_t off = (size_t)(row0 + ai * HALF + m * 16) * ldc + col0;
#pragma unroll
                for (int bj = 0; bj < 2; ++bj)
#pragma unroll
                    for (int n = 0; n < 2; ++n) { const f32x4 bs = *(const f32x4*)(base + off + bj * HALF + n * 16); *(f32x4*)(C + off + bj * HALF + n * 16) = bs + acc[ai][bj][m][n]; }
                asm volatile("" ::: "memory"); }
    }
};
__device__ __forceinline__ float silu_mul(float a, float u) { return a * u * __builtin_amdgcn_rcpf(1.0f + __builtin_amdgcn_exp2f(-1.4426950408889634f * a)); }
struct EpiSwiGlu8 {
    static constexpr bool PERM = true, HEADSPLIT = false, HAS_PRE = true;
    unsigned char* O; int ldc; float si, so; const float* rs;
    __device__ __forceinline__ void prefetch(const Unit& u, float (&pre)[8], int wr, int fr) const {
        const int row0 = u.pm * BM + wr * 64 + fr;
#pragma unroll
        for (int ai = 0; ai < 2; ++ai)
#pragma unroll
            for (int m = 0; m < 4; ++m) pre[ai * 4 + m] = rs[row0 + ai * HALF + m * 16];
    }
    __device__ __forceinline__ void operator()(const f32x4 (&acc)[2][2][4][2], const Unit& u, int wr, int wc, int fr, int fq, const float (&pre)[8]) const {
        const int row0 = u.pm * BM + wr * 64 + fr, col0 = u.pn * HALF + wc * 32 + 8 * fq;
#pragma unroll
        for (int ai = 0; ai < 2; ++ai)
#pragma unroll
            for (int m = 0; m < 4; ++m) { const int row = row0 + ai * HALF + m * 16; unsigned char* rowp = O + (size_t)row * ldc + col0;
                const float sg = si * pre[ai * 4 + m], k1 = -1.4426950408889634f * sg, k2 = sg * sg * so;
                float r[8];
#pragma unroll
                for (int n = 0; n < 2; ++n)
#pragma unroll
                    for (int e = 0; e < 4; ++e) { const float gg = acc[ai][0][m][n][e], uu = acc[ai][1][m][n][e];
                        r[4 * n + e] = (gg * uu) * (k2 * __builtin_amdgcn_rcpf(1.0f + __builtin_amdgcn_exp2f(k1 * gg))); }
                u32x2 w; w.x = pk4_fp8(r[0], r[1], r[2], r[3]); w.y = pk4_fp8(r[4], r[5], r[6], r[7]);
                *(u32x2*)rowp = w; }
    }
};

template <class Epi, class Sched, bool ALIGN_EPI = false, bool SP2 = false, bool FP8 = false, bool GATHER = false>
__device__ __forceinline__ void gemm_phase(PG8_LAS unsigned char* lds, const Gemm g, const Sched& S, const Epi& E) {
    int tid = threadIdx.x; asm volatile("" : "+v"(tid));
    const int wid = __builtin_amdgcn_readfirstlane(tid >> 6), lane = tid & 63, wr = wid >> 2, wc = wid & 3, fr = lane & 15, fq = lane >> 4;
    const int K = g.K, nt = K / BK;
    unsigned voffA[2], voffB[2]; int stR[2], stC[2];
#pragma unroll
    for (int i = 0; i < 2; ++i) { int R, C; stage_rc(tid * 16 + i * 8192, R, C); const int Rb = Epi::HEADSPLIT ? (128 * (R >> 6) + 64 * ((R >> 5) & 1) + perm32(R & 31)) : (Epi::PERM ? ((R & ~31) + perm32(R & 31)) : R);
        voffA[i] = (unsigned)(R * K + C) * 2u; voffB[i] = (unsigned)(Rb * K + C) * 2u; stR[i] = R; stC[i] = C; }
    const size_t kstep = (size_t)(BK * 2);
    const size_t hA = (size_t)HALF * K * 2, hB = g.bh;
    const size_t tstepA = 2 * hA;
    const unsigned ldsw = (unsigned)wid * 1024u;
    const int aoff = lds_byte(wr * 64 + fr, fq * 8), boff = lds_byte(wc * 32 + fr, fq * 8);
#define PG8_SA(b, h) (((b) * 2 + (h)) * HTB)
#define PG8_SB(b, h) ((4 + (b) * 2 + (h)) * HTB)
#define PG8_STAGE(bufoff, gbase, voff) do { _Pragma("unroll") for (int _i = 0; _i < 2; ++_i) \
        __builtin_amdgcn_global_load_lds((const unsigned*)((const char*)(gbase) + (voff)[_i]), (PG8_LAS unsigned*)(lds + (bufoff) + ldsw + _i * 8192), 16, 0, 0); } while (0)
#define PG8_LDA(dst, b, h) do { _Pragma("unroll") for (int m = 0; m < 4; ++m) _Pragma("unroll") for (int k = 0; k < 2; ++k) dst[m][k] = *(const PG8_LAS bf16x8*)(lds + PG8_SA(b, h) + aoff + m * 2048 + k * 1024); } while (0)
#define PG8_LDB(dst, b, h) do { _Pragma("unroll") for (int n = 0; n < 2; ++n) _Pragma("unroll") for (int k = 0; k < 2; ++k) dst[n][k] = *(const PG8_LAS bf16x8*)(lds + PG8_SB(b, h) + boff + n * 2048 + k * 1024); } while (0)
#define PG8_CAT(x) __builtin_shufflevector(__builtin_bit_cast(i32x4, (x)[0]), __builtin_bit_cast(i32x4, (x)[1]), 0, 1, 2, 3, 4, 5, 6, 7)
#define PG8_MMA(ai, bj, At, Bt) do { __builtin_amdgcn_s_setprio(1); _Pragma("unroll") for (int m = 0; m < 4; ++m) _Pragma("unroll") for (int n = 0; n < 2; ++n) { \
        if constexpr (FP8) { asm volatile("v_mfma_scale_f32_16x16x128_f8f6f4 %0, %1, %2, %0, %3, %3 op_sel_hi:[0,0,0]" : "+v"(acc[ai][bj][m][n]) : "v"(PG8_CAT(Bt[n])), "v"(PG8_CAT(At[m])), "v"(unit_scale)); } \
        else { _Pragma("unroll") for (int k = 0; k < 2; ++k) acc[ai][bj][m][n] = __builtin_amdgcn_mfma_f32_16x16x32_bf16(Bt[n][k], At[m][k], acc[ai][bj][m][n], 0, 0, 0); } } \
        __builtin_amdgcn_s_setprio(0); } while (0)
#define PG8_WAIT_V(n) asm volatile("s_waitcnt vmcnt(" #n ")" ::: "memory")
#define PG8_WAIT_L(n) asm volatile("s_waitcnt lgkmcnt(" #n ")" ::: "memory")
#define PG8_BAR __builtin_amdgcn_s_barrier()
#define PG8_SCHED __builtin_amdgcn_sched_barrier(0)
    Unit cur, nxt; int ui = 0;
    if (!S.next(0, cur)) return;
    const int unit_scale = 0x7f7f7f7f; (void)unit_scale;
    f32x4 acc[2][2][4][2];
#pragma unroll
    for (int a = 0; a < 2; ++a)
#pragma unroll
        for (int b = 0; b < 2; ++b)
#pragma unroll
            for (int m = 0; m < 4; ++m)
#pragma unroll
                for (int n = 0; n < 2; ++n) acc[a][b][m][n] = (f32x4){0.f, 0.f, 0.f, 0.f};
    bf16x8 At[4][2], B0[2][2], B1[2][2];
    const char* cA = GATHER ? (const char*)g.A : (const char*)g.A + (size_t)cur.pm * tstepA; const char* cB = (const char*)g.Bt + (size_t)(cur.pm >> 3) * g.be + (size_t)cur.pn * g.bt;
    S.a_ready(cur);
    unsigned gc[2][2], gn[2][2];
    if constexpr (GATHER) {
#pragma unroll
        for (int h = 0; h < 2; ++h)
#pragma unroll
            for (int i = 0; i < 2; ++i) { const int tok = g.gidx[cur.pm * BM + h * HALF + stR[i]]; gc[h][i] = (unsigned)(((((cur.pm >> 1) & 3) * SEQ + tok) * K + stC[i]) * 2); gn[h][i] = gc[h][i]; }
    }
#define PG8_OA(h, nx) (GATHER ? ((nx) ? gn[h] : gc[h]) : voffA)
#define PG8_HA(h) (GATHER ? (size_t)0 : (size_t)(h) * hA)
    float pre[8]; (void)pre;
    if constexpr (Epi::HAS_PRE) E.prefetch(cur, pre, wr, fr);
    if constexpr (SP2) {
        PG8_STAGE(PG8_SB(0, 0), cB, voffB); PG8_STAGE(PG8_SB(0, 1), cB + hB, voffB); PG8_STAGE(PG8_SA(0, 0), cA, PG8_OA(0, false)); PG8_STAGE(PG8_SA(0, 1), cA + PG8_HA(1), PG8_OA(1, false));
        if (wr == 1) PG8_BAR;
        PG8_WAIT_V(2); PG8_BAR;
        PG8_STAGE(PG8_SB(1, 0), cB + kstep, voffB); PG8_STAGE(PG8_SA(1, 0), cA + kstep, PG8_OA(0, false)); PG8_STAGE(PG8_SB(1, 1), cB + hB + kstep, voffB);
        PG8_WAIT_V(6); PG8_BAR;
    } else {
        PG8_STAGE(PG8_SB(0, 0), cB, voffB); PG8_STAGE(PG8_SA(0, 0), cA, PG8_OA(0, false)); PG8_STAGE(PG8_SB(0, 1), cB + hB, voffB); PG8_STAGE(PG8_SA(0, 1), cA + PG8_HA(1), PG8_OA(1, false));
        if (wr == 1) PG8_BAR;
        PG8_WAIT_V(4); PG8_BAR;
        PG8_STAGE(PG8_SB(1, 0), cB + kstep, voffB); PG8_STAGE(PG8_SA(1, 0), cA + kstep, PG8_OA(0, false)); PG8_STAGE(PG8_SB(1, 1), cB + hB + kstep, voffB);
        PG8_WAIT_V(6); PG8_BAR;
    }
    for (;;) {
        const bool has_next = S.next(ui + 1, nxt);
        if constexpr (GATHER) { if (has_next && wid == 0)
            __builtin_amdgcn_global_load_lds((const unsigned*)(g.gidx + nxt.pm * BM + lane * 4), (PG8_LAS unsigned*)(g.gtab + ((ui + 1) & 1) * BM), 16, 0, 0); }
        const char* nA = GATHER ? cA : (has_next ? (const char*)g.A + (size_t)nxt.pm * tstepA : cA); const char* nB = has_next ? (const char*)g.Bt + (size_t)(nxt.pm >> 3) * g.be + (size_t)nxt.pn * g.bt : cB;
        for (int t = 0; t < nt; t += 2) {
            const bool last = (t == nt - 2);
            const char* a1 = cA + (size_t)(t + 1) * kstep;
            const char* a2 = last ? nA : cA + (size_t)(t + 2) * kstep; const char* b2 = last ? nB : cB + (size_t)(t + 2) * kstep;
            const char* a3 = a2 + kstep; const char* b3 = b2 + kstep;
            if (last && has_next) S.a_ready(nxt);
            if constexpr (GATHER) { if (last && has_next) {
#pragma unroll
                for (int h = 0; h < 2; ++h)
#pragma unroll
                    for (int i = 0; i < 2; ++i) { const int tok = g.gtab[((ui + 1) & 1) * BM + h * HALF + stR[i]]; gn[h][i] = (unsigned)(((((nxt.pm >> 1) & 3) * SEQ + tok) * K + stC[i]) * 2); } } }
            if constexpr (SP2) {
            PG8_LDB(B0, 0, 0); PG8_LDB(B1, 0, 1); PG8_SCHED; PG8_LDA(At, 0, 0); PG8_STAGE(PG8_SA(1, 1), a1 + PG8_HA(1), PG8_OA(1, false));
            PG8_WAIT_V(8); PG8_WAIT_L(0); PG8_BAR; PG8_MMA(0, 0, At, B0); PG8_MMA(0, 1, At, B1); PG8_BAR; PG8_SCHED;
            PG8_LDA(At, 0, 1); PG8_STAGE(PG8_SB(0, 0), b2, voffB); PG8_STAGE(PG8_SB(0, 1), b2 + hB, voffB); PG8_STAGE(PG8_SA(0, 0), a2, PG8_OA(0, last));
            PG8_WAIT_V(8); PG8_WAIT_L(0); PG8_BAR; PG8_MMA(1, 0, At, B0); PG8_MMA(1, 1, At, B1); PG8_BAR; PG8_SCHED;
            PG8_LDB(B0, 1, 0); PG8_LDB(B1, 1, 1); PG8_SCHED; PG8_LDA(At, 1, 0); PG8_STAGE(PG8_SA(0, 1), a2 + PG8_HA(1), PG8_OA(1, last));
            PG8_WAIT_V(8); PG8_WAIT_L(0); PG8_BAR; PG8_MMA(0, 0, At, B0); PG8_MMA(0, 1, At, B1); PG8_BAR; PG8_SCHED;
            PG8_LDA(At, 1, 1); PG8_STAGE(PG8_SB(1, 0), b3, voffB); PG8_STAGE(PG8_SB(1, 1), b3 + hB, voffB); PG8_STAGE(PG8_SA(1, 0), a3, PG8_OA(0, last));
            PG8_WAIT_V(8); PG8_WAIT_L(0); PG8_BAR; PG8_MMA(1, 0, At, B0); PG8_MMA(1, 1, At, B1); PG8_BAR; PG8_SCHED;
            } else {
            PG8_LDB(B0, 0, 0); PG8_SCHED; PG8_LDA(At, 0, 0); PG8_STAGE(PG8_SA(1, 1), a1 + PG8_HA(1), PG8_OA(1, false));
            PG8_WAIT_L(8); PG8_BAR; PG8_WAIT_L(0); PG8_MMA(0, 0, At, B0); PG8_BAR; PG8_SCHED;
            PG8_LDB(B1, 0, 1); PG8_STAGE(PG8_SB(0, 0), b2, voffB);
            PG8_BAR; PG8_WAIT_L(0); PG8_MMA(0, 1, At, B1); PG8_BAR;
            PG8_LDA(At, 0, 1); PG8_STAGE(PG8_SA(0, 0), a2, PG8_OA(0, last));
            PG8_BAR; PG8_WAIT_L(0); PG8_MMA(1, 0, At, B0); PG8_BAR; PG8_SCHED;
            PG8_STAGE(PG8_SB(0, 1), b2 + hB, voffB);
            PG8_WAIT_V(6); PG8_BAR; PG8_MMA(1, 1, At, B1); PG8_BAR;
            PG8_LDB(B0, 1, 0); PG8_SCHED; PG8_LDA(At, 1, 0); PG8_STAGE(PG8_SA(0, 1), a2 + PG8_HA(1), PG8_OA(1, last));
            PG8_WAIT_L(8); PG8_BAR; PG8_WAIT_L(0); PG8_MMA(0, 0, At, B0); PG8_BAR; PG8_SCHED;
            PG8_LDB(B1, 1, 1); PG8_STAGE(PG8_SB(1, 0), b3, voffB);
            PG8_BAR; PG8_WAIT_L(0); PG8_MMA(0, 1, At, B1); PG8_BAR;
            PG8_LDA(At, 1, 1); PG8_STAGE(PG8_SA(1, 0), a3, PG8_OA(0, last));
            PG8_BAR; PG8_WAIT_L(0); PG8_MMA(1, 0, At, B0); PG8_BAR; PG8_SCHED;
            PG8_STAGE(PG8_SB(1, 1), b3 + hB, voffB);
            PG8_WAIT_V(6); PG8_BAR; PG8_MMA(1, 1, At, B1); PG8_BAR;
            }
        }
        if constexpr (ALIGN_EPI) { if (wr == 0) PG8_BAR; }
        if constexpr (FP8) asm volatile("s_nop 15\n\ts_nop 15" ::: "memory");
        if constexpr (Epi::HAS_PRE) E(acc, cur, wr, wc, fr, fq, pre); else E(acc, cur, wr, wc, fr, fq);
        S.done(cur);
        if (!has_next) break;
#pragma unroll
        for (int a = 0; a < 2; ++a)
#pragma unroll
            for (int b = 0; b < 2; ++b)
#pragma unroll
                for (int m = 0; m < 4; ++m)
#pragma unroll
                    for (int n = 0; n < 2; ++n) acc[a][b][m][n] = (f32x4){0.f, 0.f, 0.f, 0.f};
        cur = nxt; cA = nA; cB = nB; ++ui;
        if constexpr (GATHER) { gc[0][0] = gn[0][0]; gc[0][1] = gn[0][1]; gc[1][0] = gn[1][0]; gc[1][1] = gn[1][1]; }
        if constexpr (Epi::HAS_PRE) E.prefetch(cur, pre, wr, fr);
        if constexpr (ALIGN_EPI) { if (wr == 1) PG8_BAR; }
    }
    PG8_WAIT_V(0);
    if constexpr (!ALIGN_EPI) { if (wr == 0) PG8_BAR; }
    PG8_BAR;
#undef PG8_OA
#undef PG8_HA
#undef PG8_SA
#undef PG8_SB
#undef PG8_STAGE
#undef PG8_LDA
#undef PG8_LDB
#undef PG8_MMA
#undef PG8_CAT
#undef PG8_WAIT_V
#undef PG8_WAIT_L
#undef PG8_BAR
#undef PG8_SCHED
}
}

namespace att {
constexpr int D = 128, NW = 8, QBLK = 32, KVBLK = 64;
constexpr float SCALE = 0.088388347648318440f;
constexpr float THR = 8.f;
constexpr int LDQ = DIN, LDK = DIN, LDO = DM;
constexpr size_t SHM_V = KVBLK * D * 2, SHM_K = KVBLK * D * 2, SHM_ATTN = 2 * SHM_V + 2 * SHM_K + NW * 64 * 4;
using bf16x8 = __attribute__((ext_vector_type(8))) short;
using s16x4  = __attribute__((ext_vector_type(4))) short;
using f32x16 = __attribute__((ext_vector_type(16))) float;
using u32x4  = __attribute__((ext_vector_type(4))) unsigned;
#define KSWZ(row, colB) ((row) * 256 + ((colB) ^ (((row) & 7) << 4)))
#define SBAR() __builtin_amdgcn_sched_barrier(0)
__device__ __forceinline__ int crow(int r, int hi) { return (r & 3) + 8 * (r >> 2) + 4 * hi; }
__device__ __forceinline__ unsigned cvtpk(float lo, float hi) { unsigned r; asm volatile("v_cvt_pk_bf16_f32 %0, %1, %2" : "=v"(r) : "v"(lo), "v"(hi)); return r; }
__device__ __forceinline__ bf16x8 ld8(const bf16* p) { return *reinterpret_cast<const bf16x8*>(p); }

template <bool WIN>
__device__ __forceinline__ void partialSM(f32x16& p0, f32x16& p1, float& m_reg, float& mn, float& alpha, float fdb, float nslope) {
  constexpr float C = SCALE * 1.4426950408889634f;
  if constexpr (WIN) {
#pragma unroll
    for (int r = 0; r < 16; ++r) { const float cr = (float)((r & 3) + 8 * (r >> 2));
      const float d0 = __builtin_fabsf(fdb - cr), d1 = __builtin_fabsf(fdb - 32.f - cr);
      p0[r] = d0 <= 128.f ? fmaf(nslope, d0, p0[r]) : -1e30f;
      p1[r] = d1 <= 128.f ? fmaf(nslope, d1, p1[r]) : -1e30f; }
  }
  float pmax = p0[0]; for (int r = 1; r < 16; ++r) pmax = fmaxf(pmax, p0[r]); for (int r = 0; r < 16; ++r) pmax = fmaxf(pmax, p1[r]);
  { auto rr = __builtin_amdgcn_permlane32_swap(__float_as_uint(pmax), __float_as_uint(pmax), false, false);
    pmax = fmaxf(__uint_as_float(rr[0]), __uint_as_float(rr[1])); }
  if (__builtin_expect(__all(pmax - m_reg <= THR / SCALE), 1)) { mn = m_reg; alpha = 1.f; }
  else { mn = fmaxf(m_reg, pmax); alpha = __builtin_amdgcn_exp2f((m_reg - mn) * C); m_reg = mn; }
  float mnC = -mn * C;
  for (int r = 0; r < 16; ++r) p0[r] = fmaf(p0[r], C, mnC); for (int r = 0; r < 16; ++r) p1[r] = fmaf(p1[r], C, mnC);
  for (int r = 0; r < 16; ++r) p0[r] = __builtin_amdgcn_exp2f(p0[r]);
}
__device__ __forceinline__ void finishSM(f32x16& p0, f32x16& p1, float alpha, float& l_reg, bf16x8& pa0, bf16x8& pa1, bf16x8& pa2, bf16x8& pa3) {
  for (int r = 0; r < 16; ++r) p1[r] = __builtin_amdgcn_exp2f(p1[r]);
  float ps = 0; for (int r = 0; r < 16; ++r) ps += p0[r]; for (int r = 0; r < 16; ++r) ps += p1[r];
  { auto rr = __builtin_amdgcn_permlane32_swap(__float_as_uint(ps), __float_as_uint(ps), false, false);
    ps = __uint_as_float(rr[0]) + __uint_as_float(rr[1]); }
  l_reg = l_reg * alpha + ps;
#define PK4(P, BASE, OUT) do { unsigned a0 = cvtpk(P[BASE + 0], P[BASE + 1]), a1 = cvtpk(P[BASE + 2], P[BASE + 3]);   \
    unsigned b0 = cvtpk(P[BASE + 4], P[BASE + 5]), b1 = cvtpk(P[BASE + 6], P[BASE + 7]);                              \
    auto r0 = __builtin_amdgcn_permlane32_swap(a0, b0, false, false); auto r1 = __builtin_amdgcn_permlane32_swap(a1, b1, false, false); \
    u32x4 w = {r0[0], r1[0], r0[1], r1[1]}; OUT = *reinterpret_cast<bf16x8*>(&w); } while (0)
  PK4(p0, 0, pa0); PK4(p0, 8, pa1); PK4(p1, 0, pa2); PK4(p1, 8, pa3);
#undef PK4
}
__device__ __forceinline__ void qkt(f32x16& p0, f32x16& p1, const bf16* Ks, const bf16x8* qr, int r32, int hi) {
  p0 = f32x16{}; p1 = f32x16{};
  for (int d0 = 0; d0 < 8; ++d0) { int cb = (d0 * 16 + hi * 8) * 2;
    bf16x8 b0 = *reinterpret_cast<const bf16x8*>((const char*)Ks + KSWZ(r32, cb));
    bf16x8 b1 = *reinterpret_cast<const bf16x8*>((const char*)Ks + KSWZ(32 + r32, cb));
    p0 = __builtin_amdgcn_mfma_f32_32x32x16_bf16(b0, qr[d0], p0, 0, 0, 0);
    p1 = __builtin_amdgcn_mfma_f32_32x32x16_bf16(b1, qr[d0], p1, 0, 0, 0); }
}
__device__ __forceinline__ int v_st(int k, int c) { const int kk = (k & ~0xC) | ((k & 4) << 1) | ((k & 8) >> 1); return ((kk >> 3) * 4 + (c >> 5)) * 512 + ((kk & 7) * 32 + (c & 31)) * 2; }
__device__ __forceinline__ int v_rd_base(int lane) { return ((lane & 3) << 3) | (((lane >> 2) & 3) << 6) | (((lane >> 4) & 1) << 5) | (((lane >> 5) & 1) << 8); }
constexpr int v_rd_off(int d0, int ks, int half) { return d0 * 512 + ks * 4096 + half * 2048; }
template <int OFF> __device__ __forceinline__ s16x4 tr_read(int vb) {
  s16x4 r; asm volatile("ds_read_b64_tr_b16 %0, %1 offset:%2" : "=&v"(r) : "v"(vb), "i"(OFF) : "memory"); return r;
}
template <int D0> __device__ __forceinline__ void pv_one(f32x16& od, int vb, bf16x8 pa0, bf16x8 pa1, bf16x8 pa2, bf16x8 pa3) {
  const s16x4 l0 = tr_read<v_rd_off(D0, 0, 0)>(vb), h0 = tr_read<v_rd_off(D0, 0, 1)>(vb), l1 = tr_read<v_rd_off(D0, 1, 0)>(vb), h1 = tr_read<v_rd_off(D0, 1, 1)>(vb);
  const s16x4 l2 = tr_read<v_rd_off(D0, 2, 0)>(vb), h2 = tr_read<v_rd_off(D0, 2, 1)>(vb), l3 = tr_read<v_rd_off(D0, 3, 0)>(vb), h3 = tr_read<v_rd_off(D0, 3, 1)>(vb);
  asm volatile("s_waitcnt lgkmcnt(0)" ::: "memory"); SBAR();
#define PK(L, H) (bf16x8){L[0], L[1], L[2], L[3], H[0], H[1], H[2], H[3]}
  od = __builtin_amdgcn_mfma_f32_32x32x16_bf16(pa0, PK(l0, h0), od, 0, 0, 0);
  od = __builtin_amdgcn_mfma_f32_32x32x16_bf16(pa1, PK(l1, h1), od, 0, 0, 0);
  od = __builtin_amdgcn_mfma_f32_32x32x16_bf16(pa2, PK(l2, h2), od, 0, 0, 0);
  od = __builtin_amdgcn_mfma_f32_32x32x16_bf16(pa3, PK(l3, h3), od, 0, 0, 0);
#undef PK
}
__device__ __forceinline__ void pv_d0(f32x16* o, int vb, bf16x8 pa0, bf16x8 pa1, bf16x8 pa2, bf16x8 pa3) {
  pv_one<0>(o[0], vb, pa0, pa1, pa2, pa3); pv_one<1>(o[1], vb, pa0, pa1, pa2, pa3); pv_one<2>(o[2], vb, pa0, pa1, pa2, pa3); pv_one<3>(o[3], vb, pa0, pa1, pa2, pa3);
}

template <bool WIN, int SDEPTH>
__device__ __forceinline__ void attn_body(const bf16* __restrict__ Qb, const bf16* __restrict__ Kh, unsigned char* __restrict__ Ob, int NT, char* lds,
                                          int qrel0, float slope, float sink) {
  int tid = threadIdx.x; asm volatile("" : "+v"(tid));
  const int wid = tid >> 6, lane = tid & 63, r32 = lane & 31, hi = lane >> 5;
  bf16* V_lds = (bf16*)lds; bf16* K_lds = (bf16*)(lds + 2 * SHM_V);
  float* ws = (float*)(lds + 2 * SHM_V + 2 * SHM_K) + wid * 64; float* li_l = ws; float* al_l = ws + 32;
  float m_reg = WIN ? sink * (1.0f / SCALE) : -1e30f, l_reg = WIN ? 1.0f : 0.f; f32x16 o[4] = {}; bf16x8 qr[8];
  const float nslope = -slope * (1.0f / SCALE);
  const float fd0 = (float)(qrel0 + wid * QBLK + r32 - 4 * hi);
  const bf16* Qw = Qb + (long)(wid * QBLK + r32) * LDQ + hi * 8;
#pragma unroll
  for (int d0 = 0; d0 < 8; ++d0) qr[d0] = ld8(Qw + d0 * 16);
  const int sr = tid >> 4, sc = (tid & 15) * 8, vst0 = v_st(sr, sc), vst1 = v_st(32 + sr, sc);
  const int vb0 = (int)(uintptr_t)V_lds + v_rd_base(lane);
  struct { bf16x8 vs0, vs1, ks0, ks1; } sr_[SDEPTH];
  const unsigned loff = (unsigned)(sr * LDK + sc) * 2u;
#define SLOAD(i, k0) do { const GAS char* tb = (const GAS char*)Kh + (size_t)(k0) * (LDK * 2); const GAS char* tb2 = tb + (size_t)32 * LDK * 2; \
    sr_[i].vs0 = *(const GAS bf16x8*)(tb + loff + 512); sr_[i].vs1 = *(const GAS bf16x8*)(tb2 + loff + 512); \
    sr_[i].ks0 = *(const GAS bf16x8*)(tb + loff); sr_[i].ks1 = *(const GAS bf16x8*)(tb2 + loff); } while (0)
#define SWRITE(b, i) do { *(bf16x8*)((char*)V_lds + (b) * SHM_V + vst0) = sr_[i].vs0;          \
    *(bf16x8*)((char*)V_lds + (b) * SHM_V + vst1) = sr_[i].vs1; int kc = sc * 2;               \
    *(bf16x8*)((char*)K_lds + (b) * SHM_K + KSWZ(sr, kc)) = sr_[i].ks0;                       \
    *(bf16x8*)((char*)K_lds + (b) * SHM_K + KSWZ(32 + sr, kc)) = sr_[i].ks1; } while (0)
#define SWAIT() do { if constexpr (SDEPTH == 2) asm volatile("s_waitcnt vmcnt(4)" ::: "memory"); else asm volatile("s_waitcnt vmcnt(0)" ::: "memory"); } while (0)
#define RESC(a) do { if (__any((a) < 1.f)) { if (hi == 0) al_l[r32] = (a); asm volatile("s_waitcnt lgkmcnt(0)" ::: "memory"); \
    for (int d = 0; d < 4; ++d) for (int r = 0; r < 16; ++r) o[d][r] *= al_l[crow(r, hi)]; } } while (0)
  f32x16 pA0, pA1, pB0, pB1; float mnA, mnB, alA, alB; bf16x8 pa0, pa1, pa2, pa3;
  constexpr int SE = 0, SO = SDEPTH - 1;
  const int wq0 = WIN ? __builtin_amdgcn_readfirstlane(qrel0 + wid * QBLK) : 0;
#define NEED(t) (!WIN || (64 * (t) <= wq0 + 159 && 64 * (t) + 63 >= wq0 - 128))
  bool nA = NEED(0), nB = true;
  SLOAD(SE, 0); asm volatile("s_waitcnt vmcnt(0)" ::: "memory"); SWRITE(0, SE); __syncthreads();
  if (nA) { qkt(pA0, pA1, K_lds, qr, r32, hi); partialSM<WIN>(pA0, pA1, m_reg, mnA, alA, fd0, nslope); }
  SLOAD(SO, KVBLK); if constexpr (SDEPTH == 2) { if (2 < NT) SLOAD(SE, 2 * KVBLK); }
  SWAIT(); SWRITE(1, SO); __syncthreads();
  for (int j = 1; j + 1 < NT; j += 2) {
    nB = NEED(j);
    SBAR(); if (nB) qkt(pB0, pB1, (bf16*)((char*)K_lds + SHM_K), qr, r32, hi);
    if (nA) finishSM(pA0, pA1, alA, l_reg, pa0, pa1, pa2, pa3); SBAR();
    SLOAD(SO, (j + SDEPTH) * KVBLK); SBAR();
    if (nA) pv_d0(o, vb0, pa0, pa1, pa2, pa3); if (nB) partialSM<WIN>(pB0, pB1, m_reg, mnB, alB, fd0 - 64.f * (float)j, nslope);
    __syncthreads(); SWAIT(); SWRITE(0, SE);
    if (nB) RESC(alB); __syncthreads();
    nA = NEED(j + 1);
    SBAR(); if (nA) qkt(pA0, pA1, K_lds, qr, r32, hi);
    if (nB) finishSM(pB0, pB1, alB, l_reg, pa0, pa1, pa2, pa3); SBAR();
    if (SDEPTH == 1 || j + 3 < NT) SLOAD(SE, (j + 1 + SDEPTH) * KVBLK); SBAR();
    if (nB) pv_d0(o, vb0 + (int)SHM_V, pa0, pa1, pa2, pa3); if (nA) partialSM<WIN>(pA0, pA1, m_reg, mnA, alA, fd0 - 64.f * (float)(j + 1), nslope);
    __syncthreads(); SWAIT(); SWRITE(1, SO);
    if (nA) RESC(alA); __syncthreads();
  }
  nB = NEED(NT - 1);
  SBAR(); if (nB) qkt(pB0, pB1, (bf16*)((char*)K_lds + SHM_K), qr, r32, hi);
  if (nA) finishSM(pA0, pA1, alA, l_reg, pa0, pa1, pa2, pa3); SBAR();
  if (nA) pv_d0(o, vb0, pa0, pa1, pa2, pa3); if (nB) partialSM<WIN>(pB0, pB1, m_reg, mnB, alB, fd0 - 64.f * (float)(NT - 1), nslope);
  __syncthreads(); if (nB) { RESC(alB);
  finishSM(pB0, pB1, alB, l_reg, pa0, pa1, pa2, pa3); SBAR();
  pv_d0(o, vb0 + (int)SHM_V, pa0, pa1, pa2, pa3); }
#undef NEED
  if (hi == 0) li_l[r32] = l_reg; asm volatile("s_waitcnt lgkmcnt(0)" ::: "memory");
  float rli[16];
#pragma unroll
  for (int r = 0; r < 16; ++r) rli[r] = __builtin_amdgcn_rcpf(li_l[crow(r, hi)]);
  unsigned char* Ow = Ob + (long)(wid * QBLK) * LDO + 4 * r32;
#pragma unroll
  for (int r = 0; r < 16; ++r) { const int orow = crow(r, hi); const float sr = rli[r] * OS;
    *(unsigned*)(Ow + (long)orow * LDO) = pk4_fp8(o[0][r] * sr, o[1][r] * sr, o[2][r] * sr, o[3][r] * sr); }
#undef SLOAD
#undef SWRITE
#undef SWAIT
#undef RESC
}

typedef int i32x8 __attribute__((ext_vector_type(8)));
typedef int i32x4 __attribute__((ext_vector_type(4)));
constexpr int SHM8 = 8192;
__device__ __forceinline__ i32x8 cat8(i32x4 a, i32x4 b) { return __builtin_shufflevector(a, b, 0, 1, 2, 3, 4, 5, 6, 7); }
__device__ __forceinline__ void mfma8(f32x16& acc, i32x8 a, i32x8 b) {
  acc = __builtin_amdgcn_mfma_scale_f32_32x32x64_f8f6f4(a, b, acc, 0, 0, 0, 0x7f7f7f7f, 0, 0x7f7f7f7f);
}
__device__ __forceinline__ void mfma8qk(f32x16& d, const f32x16& c, i32x8 a, i32x8 b) {
  d = __builtin_amdgcn_mfma_scale_f32_32x32x64_f8f6f4(a, b, c, 0, 0, 0, 0x7f7f7f7f, 0, 0x74747474);
}
template <int SDEPTH>
__device__ __forceinline__ void attn_body8(const unsigned char* __restrict__ Qb, const unsigned char* __restrict__ Kh, const unsigned char* __restrict__ VTh, unsigned char* __restrict__ Ob, int NT, char* lds) {
  constexpr float XMAX = 3.0f + 4.0f * 1.4426950408889634f;
  static_assert(PSC == 8.f, "the exponent shift below is log2(PSC) = 3");
  int tid = threadIdx.x; asm volatile("" : "+v"(tid));
  const int wid = __builtin_amdgcn_readfirstlane(tid >> 6), lane = tid & 63, r32 = lane & 31, hi = lane >> 5;
  char* K_lds = lds; char* V_lds = lds + 4 * SHM8;
  float* ws = (float*)(lds + 6 * SHM8) + wid * 64; float* al_l = ws + 32;
  f32x16 negm = {}; f32x16 o[4] = {}, o5 = {};
  char* Q_lds = lds + 6 * SHM8 + 2048;
  __syncthreads();
#pragma unroll
  for (int i = 0; i < 4; ++i) { const int idx = tid + 512 * i, row = idx >> 3, ch = idx & 7;
    *(i32x4*)(Q_lds + row * 128 + ((ch ^ ((row >> 1) & 7)) << 4)) = *(const GAS i32x4*)(Qb + (size_t)row * 1024 + 16 * ch); }
  const char* Qw = Q_lds + wid * 4096;
  const int skey = tid >> 3, skc = tid & 7, sd = tid >> 2, svc = tid & 3;
  const unsigned vst0 = (unsigned)(sd * 64 + ((((svc >> 1)) ^ ((sd >> 2) & 3)) << 4) + 8 * (svc & 1)), vst1 = (unsigned)(sd * 64 + (((2 + (svc >> 1)) ^ ((sd >> 2) & 3)) << 4) + 8 * (svc & 1));
  const unsigned kgo = (unsigned)(skey * 256 + 16 * (skc ^ ((skey >> 1) & 7)));
  const unsigned kdst = (unsigned)(uintptr_t)K_lds + (unsigned)wid * 1024u;
  const unsigned vgo = (unsigned)(sd * SEQ + 16 * svc);
  struct { i32x4 v; } sr_[SDEPTH];
#define SLOAD(i, k0) do { __builtin_amdgcn_global_load_lds((const GAS unsigned*)((const GAS char*)Kh + (size_t)(k0) * 256 + kgo), (LAS unsigned*)(kdst + ((((unsigned)(k0)) >> 6) & 3u) * (unsigned)SHM8), 16, 0, 0); \
    sr_[i].v = *(const GAS i32x4*)((const GAS char*)VTh + (k0) + vgo); } while (0)
#define SWRITE(b, i) do { \
    *(long long*)(V_lds + (b) * SHM8 + vst0) = ((long long)(unsigned)sr_[i].v[2] << 32) | (unsigned)sr_[i].v[0];   \
    *(long long*)(V_lds + (b) * SHM8 + vst1) = ((long long)(unsigned)sr_[i].v[3] << 32) | (unsigned)sr_[i].v[1]; } while (0)
#define SWAIT() do { if constexpr (SDEPTH == 2) asm volatile("s_waitcnt vmcnt(2)" ::: "memory"); else asm volatile("s_waitcnt vmcnt(0)" ::: "memory"); } while (0)
#define RESC(a) do { if (__any((a) < 1.f)) { if (hi == 0) al_l[r32] = (a); asm volatile("s_waitcnt lgkmcnt(0)" ::: "memory"); \
    for (int r = 0; r < 16; ++r) { const float f_ = al_l[crow(r, hi)]; o[0][r] *= f_; o[1][r] *= f_; o[2][r] *= f_; o[3][r] *= f_; o5[r] *= f_; } } } while (0)
  const int ks = (r32 >> 1) & 7, vs = (r32 >> 2) & 3;
  const int ka0 = r32 * 128 + (((2 * hi) ^ ks) << 4), ka1 = r32 * 128 + (((2 * hi + 1) ^ ks) << 4), ka2 = r32 * 128 + (((4 + 2 * hi) ^ ks) << 4), ka3 = r32 * 128 + (((5 + 2 * hi) ^ ks) << 4);
  const int va0 = r32 * 64 + (((2 * hi) ^ vs) << 4), va1 = r32 * 64 + (((2 * hi + 1) ^ vs) << 4);
#define QKT8(p0, p1, Kb) do { \
    { const i32x8 qa = cat8(*(const i32x4*)(Qw + ka0), *(const i32x4*)(Qw + ka1)); \
      mfma8qk(p0, negm, cat8(*(const i32x4*)((Kb) + ka0), *(const i32x4*)((Kb) + ka1)), qa); mfma8qk(p1, negm, cat8(*(const i32x4*)((Kb) + 4096 + ka0), *(const i32x4*)((Kb) + 4096 + ka1)), qa); } \
    { const i32x8 qb = cat8(*(const i32x4*)(Qw + ka2), *(const i32x4*)(Qw + ka3)); \
      mfma8qk(p0, p0, cat8(*(const i32x4*)((Kb) + ka2), *(const i32x4*)((Kb) + ka3)), qb); mfma8qk(p1, p1, cat8(*(const i32x4*)((Kb) + 4096 + ka2), *(const i32x4*)((Kb) + 4096 + ka3)), qb); } } while (0)
#define PV8(Vb, pk) do { _Pragma("unroll") for (int d0 = 0; d0 < 4; ++d0) mfma8(o[d0], pk, cat8(*(const i32x4*)((Vb) + d0 * 2048 + va0), *(const i32x4*)((Vb) + d0 * 2048 + va1))); \
    { int c38 = 0x38383838; asm volatile("" : "+v"(c38)); const i32x8 ones = {c38, c38, c38, c38, c38, c38, c38, c38}; mfma8(o5, pk, ones); } } while (0)
#define PSM8(p0, p1, alpha, FIRST) do { float pmax = p0[0]; for (int r = 1; r < 16; ++r) pmax = fmaxf(pmax, p0[r]); for (int r = 0; r < 16; ++r) pmax = fmaxf(pmax, p1[r]); \
    { auto rr = __builtin_amdgcn_permlane32_swap(__float_as_uint(pmax), __float_as_uint(pmax), false, false); pmax = fmaxf(__uint_as_float(rr[0]), __uint_as_float(rr[1])); } \
    alpha = 1.f; \
    if (FIRST || !__builtin_expect(__all(pmax <= XMAX), 1)) { const float dl = FIRST ? (pmax - 3.0f) : fmaxf(pmax - 3.0f, 0.f); alpha = __builtin_amdgcn_exp2f(-dl); \
      for (int r = 0; r < 16; ++r) { p0[r] -= dl; p1[r] -= dl; negm[r] -= dl; } } \
    for (int r = 0; r < 16; ++r) p0[r] = __builtin_amdgcn_exp2f(p0[r]); } while (0)
#define FSM8(p0, p1, pk) do { for (int r = 0; r < 16; ++r) p1[r] = __builtin_amdgcn_exp2f(p1[r]); \
    _Pragma("unroll") for (int w = 0; w < 4; ++w) { pk[w] = (int)pk4_fp8_nc(p0[4 * w], p0[4 * w + 1], p0[4 * w + 2], p0[4 * w + 3]); pk[4 + w] = (int)pk4_fp8_nc(p1[4 * w], p1[4 * w + 1], p1[4 * w + 2], p1[4 * w + 3]); } } while (0)
  f32x16 pA0, pA1, pB0, pB1; float alA, alB; i32x8 pk;
  constexpr int SE = 0, SO = SDEPTH - 1;
  __syncthreads();
  SLOAD(SE, 0); asm volatile("s_waitcnt vmcnt(0)" ::: "memory"); SWRITE(0, SE); __syncthreads();
  QKT8(pA0, pA1, K_lds); PSM8(pA0, pA1, alA, true);
  SLOAD(SO, KVBLK); if constexpr (SDEPTH == 2) { if (2 < NT) SLOAD(SE, 2 * KVBLK); }
  SWAIT(); SWRITE(1, SO); __syncthreads();
  for (int j = 1; j + 1 < NT; j += 2) {
    SBAR(); QKT8(pB0, pB1, K_lds + (j & 3) * SHM8);
    FSM8(pA0, pA1, pk); SBAR();
    SLOAD(SO, (j + SDEPTH) * KVBLK); SBAR();
    PV8(V_lds, pk); PSM8(pB0, pB1, alB, false);
    __syncthreads(); SWAIT(); SWRITE(0, SE);
    RESC(alB); __syncthreads();
    SBAR(); QKT8(pA0, pA1, K_lds + ((j + 1) & 3) * SHM8);
    FSM8(pB0, pB1, pk); SBAR();
    if (SDEPTH == 1 || j + 3 < NT) SLOAD(SE, (j + 1 + SDEPTH) * KVBLK); SBAR();
    PV8(V_lds + SHM8, pk); PSM8(pA0, pA1, alA, false);
    __syncthreads(); SWAIT(); SWRITE(1, SO);
    RESC(alA); __syncthreads();
  }
  SBAR(); QKT8(pB0, pB1, K_lds + ((NT - 1) & 3) * SHM8);
  FSM8(pA0, pA1, pk); SBAR();
  PV8(V_lds, pk); PSM8(pB0, pB1, alB, false);
  __syncthreads(); RESC(alB);
  FSM8(pB0, pB1, pk); SBAR();
  PV8(V_lds + SHM8, pk);
  unsigned char* Ow = Ob + (long)(wid * QBLK) * LDO + 4 * r32;
#pragma unroll
  for (int r = 0; r < 16; ++r) { const int orow = crow(r, hi); const float rl = __builtin_amdgcn_rcpf(o5[r] * QS);
    const float sr = rl * OS; *(unsigned*)(Ow + (long)orow * LDO) = pk4_fp8(o[0][r] * sr, o[1][r] * sr, o[2][r] * sr, o[3][r] * sr); }
#undef SLOAD
#undef SWRITE
#undef SWAIT
#undef RESC
#undef QKT8
#undef PV8
#undef PSM8
#undef FSM8
}
#undef KSWZ
#undef SBAR
}

#define XB_TMO      128
#define XB_XCNT(j)  (256  + 64 * (j))
#define XB_XSUB(j)  (1280 + 64 * (j))
#define XB_XGEN(j)  (2304 + 64 * (j))
#define XB_TOP      3328
#define XB_TOPGEN   3392
#define XCD_BAR_WORDS 3456
#define XB_SPIN_CAP (1u << 18)
__device__ __forceinline__ unsigned xb_ld(unsigned* p)              { return __hip_atomic_load(p, __ATOMIC_RELAXED, __HIP_MEMORY_SCOPE_AGENT); }
__device__ __forceinline__ unsigned xb_add(unsigned* p, unsigned v) { return __hip_atomic_fetch_add(p, v, __ATOMIC_RELAXED, __HIP_MEMORY_SCOPE_AGENT); }
__device__ __forceinline__ unsigned xb_xcc_id() { return (unsigned)__builtin_amdgcn_s_getreg((3 << 11) | 20) & 0xFu; }
#define XB_SPIN(cond, bar) do { unsigned _sp = 0; while (cond) { __builtin_amdgcn_s_sleep(1); \
    if ((++_sp & 255u) == 0u) { if (xb_ld(&(bar)[XB_TMO])) break; if (_sp > XB_SPIN_CAP) { atomicAdd(&(bar)[XB_TMO], 1u); break; } } } } while (0)
struct XcdBarrier { unsigned* bar; unsigned x; volatile LAS unsigned* st; };
__device__ __forceinline__ XcdBarrier xcd_barrier_post(unsigned* bar, volatile LAS unsigned* st) {
    XcdBarrier b; b.bar = bar; b.x = xb_xcc_id(); b.st = st;
    if (threadIdx.x == 0) (void)xb_add(&bar[XB_XCNT(b.x)], 1u);
    return b;
}
__device__ __forceinline__ void xcd_barrier_complete(unsigned* bar, unsigned x, unsigned& nloc, unsigned& nx) {
    const unsigned G = gridDim.x * gridDim.y * gridDim.z;
    unsigned sum, cnt, mine, sp = 0u;
    for (;;) {
        sum = 0u; cnt = 0u; mine = 0u;
#pragma unroll
        for (unsigned j = 0; j < 16; ++j) { const unsigned c = xb_ld(&bar[XB_XCNT(j)]); sum += c; cnt += (c > 0u) ? 1u : 0u; mine = (j == x) ? c : mine; }
        if (sum == G) break;
        __builtin_amdgcn_s_sleep(1);
        if ((++sp & 255u) == 0u) { if (xb_ld(&bar[XB_TMO])) break; if (sp > XB_SPIN_CAP) { atomicAdd(&bar[XB_TMO], 1u); break; } }
    }
    nloc = mine > 0u ? mine : 1u; nx = cnt > 0u ? cnt : 1u;
}
__device__ __forceinline__ void xcd_barrier(const XcdBarrier& b) {
    asm volatile("s_waitcnt vmcnt(0)" ::: "memory");
    __syncthreads();
    if (threadIdx.x == 0) {
        unsigned* bar = b.bar;
        __builtin_amdgcn_s_waitcnt(0);
        unsigned nloc = b.st[0], nx = b.st[1];
        if (nloc == 0u) { xcd_barrier_complete(bar, b.x, nloc, nx); b.st[0] = nloc; b.st[1] = nx; }
        const unsigned old = xb_add(&bar[XB_XSUB(b.x)], 1u);
        const unsigned gen = old / nloc;
        if (old + 1u == (gen + 1u) * nloc) {
            __builtin_amdgcn_fence(__ATOMIC_RELEASE, "agent");
            asm volatile("s_waitcnt vmcnt(0)" ::: "memory");
            const unsigned og = xb_add(&bar[XB_TOP], 1u);
            const unsigned tg = og / nx;
            if (og + 1u == (tg + 1u) * nx) xb_add(&bar[XB_TOPGEN], 1u);
            else XB_SPIN(xb_ld(&bar[XB_TOPGEN]) == tg, bar);
            __builtin_amdgcn_fence(__ATOMIC_ACQUIRE, "agent");
            xb_add(&bar[XB_XGEN(b.x)], 1u);
            asm volatile("s_waitcnt vmcnt(0)" ::: "memory");
        } else {
            XB_SPIN(xb_ld(&bar[XB_XGEN(b.x)]) == gen, bar);
            __builtin_amdgcn_fence(__ATOMIC_ACQUIRE, "agent");
            asm volatile("s_waitcnt vmcnt(0)" ::: "memory");
        }
    }
    __syncthreads();
}

__device__ __forceinline__ unsigned f2bf(float f) { unsigned u = __builtin_bit_cast(unsigned, f); return (u + 0x7fffu + ((u >> 16) & 1u)) >> 16; }
__device__ __forceinline__ unsigned pk2(float lo, float hi) { return f2bf(lo) | (f2bf(hi) << 16); }
__device__ __forceinline__ void transpose_item(const float* W, int K, int N, bf16* WT, LAS float* scr, int item, int lane) {
    const int nblk = N / 32, kb = item / nblk, nb = item % nblk, k0 = 64 * kb, n0 = 32 * nb;
    const int kr = lane >> 3, c4 = (lane & 7) * 4;
    const float* src = W + (size_t)(k0 + kr) * N + n0 + c4;
    f32x4 v[8];
#pragma unroll
    for (int i = 0; i < 8; ++i) v[i] = __builtin_nontemporal_load((const f32x4*)(src + (size_t)(8 * i) * N));
#pragma unroll
    for (int i = 0; i < 8; ++i) { LAS float* d = scr + (8 * i + kr) * 33 + c4; d[0] = v[i].x; d[1] = v[i].y; d[2] = v[i].z; d[3] = v[i].w; }
    LDS_WAIT(); asm volatile("" ::: "memory");
    const int c = lane & 7;
#pragma unroll
    for (int j = 0; j < 4; ++j) { const int n = (lane >> 3) + 8 * j; const LAS float* s = scr + (8 * c) * 33 + n;
        v4u o; o.x = pk2(s[0 * 33], s[1 * 33]); o.y = pk2(s[2 * 33], s[3 * 33]); o.z = pk2(s[4 * 33], s[5 * 33]); o.w = pk2(s[6 * 33], s[7 * 33]);
        *(v4u*)(WT + (size_t)(n0 + n) * K + k0 + 8 * c) = o; }
    LDS_WAIT(); asm volatile("" ::: "memory");
}
template <bool PERMK = false>
__device__ __forceinline__ void transpose_item8(const float* W, int K, int N, unsigned char* WT, LAS float* scr, int item, int lane, float sc) {
    const int nblk = N / 32, kb = item / nblk, nb = item % nblk, k0 = 128 * kb, n0 = 32 * nb;
    const int kr = lane >> 3, c4 = (lane & 7) * 4;
    const float* src = W + (size_t)(k0 + kr) * N + n0 + c4;
    f32x4 v[16];
#pragma unroll
    for (int i = 0; i < 16; ++i) v[i] = __builtin_nontemporal_load((const f32x4*)(src + (size_t)(8 * i) * N));
#pragma unroll
    for (int i = 0; i < 16; ++i) { LAS float* d = scr + (8 * i + kr) * 33 + c4; d[0] = v[i].x; d[1] = v[i].y; d[2] = v[i].z; d[3] = v[i].w; }
    LDS_WAIT(); asm volatile("" ::: "memory");
    const int c = lane & 7;
#pragma unroll
    for (int j = 0; j < 4; ++j) { const int n = (lane >> 3) + 8 * j;
        if constexpr (PERMK) {
            const LAS float* s = scr + (4 * c) * 33 + n; v4u o;
#define PK_(q) pk4_fp8(s[(0 * 32 + (q)) * 33] * sc, s[(1 * 32 + (q)) * 33] * sc, s[(2 * 32 + (q)) * 33] * sc, s[(3 * 32 + (q)) * 33] * sc)
            o.x = PK_(0); o.y = PK_(1); o.z = PK_(2); o.w = PK_(3);
#undef PK_
            __builtin_nontemporal_store(o, (v4u*)(WT + (size_t)(n0 + n) * K + k0 + 16 * c)); continue; }
        const LAS float* s = scr + (16 * c) * 33 + n;
        v4u o; o.x = pk4_fp8(s[0 * 33] * sc, s[1 * 33] * sc, s[2 * 33] * sc, s[3 * 33] * sc); o.y = pk4_fp8(s[4 * 33] * sc, s[5 * 33] * sc, s[6 * 33] * sc, s[7 * 33] * sc);
        o.z = pk4_fp8(s[8 * 33] * sc, s[9 * 33] * sc, s[10 * 33] * sc, s[11 * 33] * sc); o.w = pk4_fp8(s[12 * 33] * sc, s[13 * 33] * sc, s[14 * 33] * sc, s[15 * 33] * sc);
        __builtin_nontemporal_store(o, (v4u*)(WT + (size_t)(n0 + n) * K + k0 + 16 * c)); }
    LDS_WAIT(); asm volatile("" ::: "memory");
}
__device__ __forceinline__ void rms_row_to_bf16(const float* xrow, const float* g, unsigned char* orow, int lane) {
    const f32x4* xr = (const f32x4*)xrow + lane; const f32x4* gr = (const f32x4*)g + lane;
    f32x4 v[8]; float s = 0.f;
#pragma unroll
    for (int j = 0; j < 8; ++j) { v[j] = __builtin_nontemporal_load(xr + 64 * j); s += (v[j].x * v[j].x + v[j].y * v[j].y) + (v[j].z * v[j].z + v[j].w * v[j].w); }
    const float rstd = 1.0f / sqrtf(wave_sum(s) * (1.f / DM) + EPS);
    unsigned* o8 = (unsigned*)orow + lane; const float rs = rstd * HS;
#pragma unroll
    for (int j = 0; j < 8; ++j) { const f32x4 gg = gr[64 * j]; o8[64 * j] = pk4_fp8(v[j].x * rs * gg.x, v[j].y * rs * gg.y, v[j].z * rs * gg.z, v[j].w * rs * gg.w); }
}

template <int R>
__device__ __forceinline__ void rms_rows_to_bf16(const float* x0, size_t rstride, const float* g, unsigned char* o0, size_t ostride, int lane) {
    f32x4 v[R][8]; float s[R];
#pragma unroll
    for (int r = 0; r < R; ++r) { const f32x4* xr = (const f32x4*)(x0 + r * rstride) + lane; s[r] = 0.f;
#pragma unroll
        for (int j = 0; j < 8; ++j) v[r][j] = __builtin_nontemporal_load(xr + 64 * j); }
    const f32x4* gr = (const f32x4*)g + lane;
#pragma unroll
    for (int r = 0; r < R; ++r) {
#pragma unroll
        for (int j = 0; j < 8; ++j) s[r] += (v[r][j].x * v[r][j].x + v[r][j].y * v[r][j].y) + (v[r][j].z * v[r][j].z + v[r][j].w * v[r][j].w);
        const float rstd = 1.0f / sqrtf(wave_sum(s[r]) * (1.f / DM) + EPS);
        unsigned* o8 = (unsigned*)(o0 + r * ostride) + lane; const float rs = rstd * HS;
#pragma unroll
        for (int j = 0; j < 8; ++j) { const f32x4 gg = gr[64 * j]; o8[64 * j] = pk4_fp8(v[r][j].x * rs * gg.x, v[r][j].y * rs * gg.y, v[r][j].z * rs * gg.z, v[r][j].w * rs * gg.w); } }
}

constexpr int I_GU = (DM / 128) * (DFF / 32), I_DN = (DFF / 128) * (DM / 32), NFFN_ITEMS = NE * (2 * I_GU + I_DN), NSLOT = 3;
constexpr int NGU_ITEMS = 2 * NE * I_GU, GU_SHARE = (NGU_ITEMS + NSLOT - 1) / NSLOT;
__device__ __attribute__((noinline)) void ffn_conv(const float* wg, const float* wu, const float* wd, unsigned char* WG_T, unsigned char* WU_T, unsigned char* WD_T, LAS unsigned char* L, int r0, int q, int wgi, int nwg) {
    __syncthreads();
    int tid = threadIdx.x; asm volatile("" : "+v"(tid));
    const int lane = tid & 63, wave = __builtin_amdgcn_readfirstlane(tid >> 6);
    LAS float* scr = (LAS float*)(L + wave * 16896);
    const int nw = nwg * NWAVES;
    for (int li = wgi * NWAVES + wave; li < q; li += nw) {
        int r = r0 + li;
        if (r < NE * I_GU) { const int e = r / I_GU; transpose_item8(wg + (size_t)e * DM * DFF, DM, DFF, WG_T + (size_t)e * DFF * DM, scr, r % I_GU, lane, WS); continue; } r -= NE * I_GU;
        if (r < NE * I_GU) { const int e = r / I_GU; transpose_item8(wu + (size_t)e * DM * DFF, DM, DFF, WU_T + (size_t)e * DFF * DM, scr, r % I_GU, lane, WS); continue; } r -= NE * I_GU;
        { const int e = r / I_DN; transpose_item8(wd + (size_t)e * DFF * DM, DFF, DM, WD_T + (size_t)e * DM * DFF, scr, r % I_DN, lane, WDS); }
    }
    __syncthreads();
}

struct Args { const float* in[13]; float* out; unsigned char* ws; int ph_lo, ph_hi; };

__global__ void __launch_bounds__(NWAVES * 64, 2) hymba_fwd(Args args) {
    extern __shared__ __attribute__((aligned(16))) unsigned char lds[];
    LAS unsigned char* L = (LAS unsigned char*)lds;
    volatile LAS unsigned* MISC = (volatile LAS unsigned*)(L + MISC_OFF);
    const int G = gridDim.x; const int bx = blockIdx.x; const int vcu = (G % 8 == 0) ? (bx % 8) * (G / 8) + bx / 8 : bx;
    const int NGW = G * NWAVES;
#define PH_IDS int tid = threadIdx.x; asm volatile("" : "+v"(tid)); const int lane = tid & 63, wave = __builtin_amdgcn_readfirstlane(tid >> 6), gw = vcu * NWAVES + wave; (void)lane; (void)gw;
    unsigned char* ws = args.ws;
    unsigned* ctl = (unsigned*)(ws + WS_CTL);
    for (int u = threadIdx.x; u < (LDS_BYTES - LDSCTL_OFF) / 4; u += NWAVES * 64) ((LAS unsigned*)(L + LDSCTL_OFF))[u] = 0u;
    __syncthreads();
    XcdBarrier bar; bar.bar = ctl + CW_BAR; bar.x = 0; bar.st = nullptr;
    if (!MK_SPLIT) bar = xcd_barrier_post(ctl + CW_BAR, MISC + 8);
#define GRID_BAR() do { if (!MK_SPLIT) xcd_barrier(bar); } while (0)
    const int lo = args.ph_lo, hi = args.ph_hi;
#ifdef PH_ONLY
#define IN(k) ((k) == PH_ONLY && lo <= (k) && (k) < hi)
#else
#define IN(k) (lo <= (k) && (k) < hi)
#endif
#define BOTH(k) (IN(k) && IN((k) + 1))

    const float* x = args.in[0];
    unsigned char* WIN_T = ws + WS_WIN; unsigned char* WOUT_T = ws + WS_WOUT; unsigned char* WG_T = ws + WS_WG; unsigned char* WU_T = ws + WS_WU; unsigned char* WD_T = ws + WS_WD;
    unsigned char* HN = ws + WS_HN; bf16* PROJ = (bf16*)(ws + WS_PROJ); unsigned char* ATT = ws + WS_ATT; bf16* MIX = (bf16*)(ws + WS_HN); float* RSTD = (float*)(ws + WS_RSTD); float* RS = (float*)(ws + WS_RS);
    unsigned char* Q8 = ws + WS_Q8; unsigned char* K8 = ws + WS_K8; unsigned char* VT8 = ws + WS_VT8;
    unsigned char* XG = ws + WS_XG; unsigned char* H8 = ws + WS_H8; unsigned char* ACT = ws + WS_ACT; bf16* EO = (bf16*)(ws + WS_EO);
    bf16* X1 = (bf16*)(ws + WS_PROJ);
    float* AFF = (float*)(ws + WS_AFF); int* IDX = (int*)(ws + WS_IDX); float* GATE = (float*)(ws + WS_GATE); int* SLOT = (int*)(ws + WS_SLOT);

    if (IN(0)) REP(0) {
        PH_IDS
        LAS float* scr = (LAS float*)(L + wave * 16896);
        constexpr int I_IN = (DM / 128) * (DIN / 32), I_OUT = (DM / 128) * (DM / 32);
        for (int it = gw; it < I_IN + I_OUT; it += NGW) {
            if (it < I_IN) transpose_item8<false>(args.in[2], DM, DIN, WIN_T, scr, it, lane, WIS);
            else transpose_item8<true>(args.in[6], DM, DM, WOUT_T, scr, it - I_IN, lane, WIS);
        }
        { int m = gw;
          for (; m + 3 * NGW < T; m += 4 * NGW) rms_rows_to_bf16<4>(x + (size_t)m * DM, (size_t)NGW * DM, args.in[1], HN + (size_t)m * DM, (size_t)NGW * DM, lane);
          for (; m < T; m += NGW) rms_row_to_bf16(x + (size_t)m * DM, args.in[1], HN + (size_t)m * DM, lane); }
        if (BOTH(0)) GRID_BAR();
    }

    if (IN(1)) REP(1) {
        pg8::Gemm g{(const pg8::bf16_t*)HN, (const pg8::bf16_t*)WIN_T, DM / 2, T / 256, DIN / 256, (size_t)32 * DM, (size_t)256 * DM, 0, nullptr, nullptr};
        pg8::StaticOrder S; S.WGM = WGM_P1; S.init(T / 256, DIN / 256, G, bx);
        LAS float* rtab = (LAS float*)(L + RING_BYTES + 4096);
        for (int idx = threadIdx.x; idx < 64 * 32; idx += NWAVES * 64) { float a = (float)(idx >> 5) * __builtin_amdgcn_exp2f(-(float)(idx & 31) * (13.287712379549449f / 32.0f)) * 0.15915494309189535f; a -= floorf(a);
            rtab[2 * idx] = __builtin_amdgcn_cosf(a); rtab[2 * idx + 1] = __builtin_amdgcn_sinf(a); }
        __syncthreads();
        pg8::EpiProj E{PROJ, DIN, args.in[4], args.in[5], (LAS float*)(L + RING_BYTES), rtab, 1.0f / (HS * WIS), Q8, K8, VT8};
        pg8::gemm_phase<pg8::EpiProj, pg8::StaticOrder, true, true, true>(L, g, S, E);
        if (BOTH(1)) GRID_BAR();
    }


    if (IN(3)) REP(3) {
        const int slot = vcu % NSLOT; int seq = 0; bool conv_done = false;
#define FFN_CONV() do { const int r0_ = slot * GU_SHARE, q_ = (NGU_ITEMS - r0_) < GU_SHARE ? (NGU_ITEMS - r0_) : GU_SHARE; \
            ffn_conv(args.in[9], args.in[10], args.in[11], WG_T, WU_T, WD_T, L, r0_, q_, vcu / NSLOT, (G - slot + NSLOT - 1) / NSLOT); conv_done = true; } while (0)
        for (int U = vcu; U < 512; U += G, ++seq) {
            if (slot == seq && !conv_done) FFN_CONV();
            const int combo = (U >> 5) & 7, j = (U >> 8) * 32 + (U & 31);
            const int b = combo >> 1, kvh = combo & 1, h = kvh * 4 + (j >> 4), qb = j & 15, q0 = qb * 256;
            const size_t rowb = (size_t)b * SEQ;
            att::attn_body8<ATT_SD_B>(Q8 + (rowb + q0) * 1024 + h * HD, K8 + rowb * 256 + kvh * HD, VT8 + (size_t)(b * 2 + kvh) * HD * SEQ,
                                  ATT + (rowb + q0) * DM + 1024 + h * HD, SEQ / 64, (char*)lds);
        }
        if (slot <= 2 && !conv_done) FFN_CONV();
        for (int U = vcu; U < 512; U += G) {
            const int combo = (U >> 5) & 7, j = (U >> 8) * 32 + (U & 31);
            const int b = combo >> 1, kvh = combo & 1, h = kvh * 4 + (j >> 4), qb = j & 15, q0 = qb * 256;
            const size_t rowb = (size_t)b * SEQ;
            const int klo = q0 >= 128 ? q0 - 128 : 0, khi = (q0 + 384 <= SEQ) ? q0 + 384 : SEQ;
            att::attn_body<true, ATT_SD_A>(PROJ + (rowb + q0) * DIN + COL_QA + h * HD, PROJ + (rowb + klo) * DIN + COL_KA + kvh * HD,
                                 ATT + (rowb + q0) * DM + h * HD, (khi - klo) / 64, (char*)lds, q0 - klo, __builtin_amdgcn_exp2f(-(float)(h + 1)), args.in[3][h]);
        }
        if (!conv_done) FFN_CONV();
#undef FFN_CONV
        if (BOTH(3)) GRID_BAR();
    }

    if (IN(4)) REP(4) {
        pg8::Gemm g{(const pg8::bf16_t*)ATT, (const pg8::bf16_t*)WOUT_T, DM / 2, T / 256, DM / 256, (size_t)128 * DM, (size_t)256 * DM, 0, nullptr, nullptr};
        pg8::StaticOrder S; S.WGM = WGM_P4; S.init(T / 256, DM / 256, G, bx);
        pg8::EpiBf16 E{MIX, DM, 1.0f / (OS * WIS)};
        pg8::gemm_phase<pg8::EpiBf16, pg8::StaticOrder, true, true, true>(L, g, S, E);
        if (BOTH(4)) GRID_BAR();
    }

    if (IN(5)) REP(5) {
        PH_IDS
        constexpr int WST = DM + 4;
        LAS float* wT = (LAS float*)L; LAS float* gL = (LAS float*)(L + NE * WST * 4); LAS float* comb = (LAS float*)(L + NE * WST * 4 + DM * 4);
        static_assert(NE * WST * 4 + DM * 4 + 4 * 64 * 5 * 4 <= LDSCTL_OFF, "P5 LDS map");
        for (int idx = tid; idx < NE * DM; idx += NWAVES * 64) { const int e = idx & 15, d = idx >> 4; wT[e * WST + d] = args.in[8][idx] * args.in[7][d]; }
        for (int d = tid; d < DM; d += NWAVES * 64) gL[d] = args.in[7][d];
        __syncthreads();
        const int j = lane & 15, kq = lane >> 4, gi = wave & 3, kh = wave >> 2;
        for (int base = vcu * 4; base < T / 16; base += G * 4) {
            asm volatile("" ::: "memory");
            const int t0 = (base + gi) * 16;
            const size_t rowoff = (size_t)(t0 + j) * DM + kh * 1024 + 8 * kq;
            const float* xp = x + rowoff; const bf16* mp = MIX + rowoff; unsigned char* hp = H8 + rowoff; bf16* x1p = X1 + rowoff;
            const LAS float* wp = wT + j * WST + kh * 1024 + 8 * kq; const LAS float* gp = gL + kh * 1024 + 8 * kq;
            f32x4 acc = {0.f, 0.f, 0.f, 0.f}; float ss = 0.f;
            f32x4 xa[2][4], xb[2][4]; v4u mm[2][4];
#define P5_LOAD(bf, bt) do { _Pragma("unroll") for (int u = 0; u < 4; ++u) { const int m = (bt) * 4 + u; xa[bf][u] = *(const f32x4*)(xp + 32 * m); xb[bf][u] = *(const f32x4*)(xp + 32 * m + 4); mm[bf][u] = *(const v4u*)(mp + 32 * m); } } while (0)
#define P5_COMP(bf, bt) do { _Pragma("unroll") for (int u = 0; u < 4; ++u) { const int m = (bt) * 4 + u; \
                const f32x4 wa = *(const LAS f32x4*)(wp + 32 * m), wb = *(const LAS f32x4*)(wp + 32 * m + 4), ga = *(const LAS f32x4*)(gp + 32 * m), gb = *(const LAS f32x4*)(gp + 32 * m + 4); \
                f32x4 a = xa[bf][u], b = xb[bf][u]; const v4u q = mm[bf][u]; \
                a.x += bf_lo(q.x); a.y += bf_hi(q.x); a.z += bf_lo(q.y); a.w += bf_hi(q.y); b.x += bf_lo(q.z); b.y += bf_hi(q.z); b.z += bf_lo(q.w); b.w += bf_hi(q.w); \
                acc = __builtin_amdgcn_mfma_f32_16x16x4f32(wa.x, a.x, acc, 0, 0, 0); acc = __builtin_amdgcn_mfma_f32_16x16x4f32(wa.y, a.y, acc, 0, 0, 0); \
                acc = __builtin_amdgcn_mfma_f32_16x16x4f32(wa.z, a.z, acc, 0, 0, 0); acc = __builtin_amdgcn_mfma_f32_16x16x4f32(wa.w, a.w, acc, 0, 0, 0); \
                acc = __builtin_amdgcn_mfma_f32_16x16x4f32(wb.x, b.x, acc, 0, 0, 0); acc = __builtin_amdgcn_mfma_f32_16x16x4f32(wb.y, b.y, acc, 0, 0, 0); \
                acc = __builtin_amdgcn_mfma_f32_16x16x4f32(wb.z, b.z, acc, 0, 0, 0); acc = __builtin_amdgcn_mfma_f32_16x16x4f32(wb.w, b.w, acc, 0, 0, 0); \
                ss += (a.x * a.x + a.y * a.y) + (a.z * a.z + a.w * a.w) + (b.x * b.x + b.y * b.y) + (b.z * b.z + b.w * b.w); \
                v2u o; o.x = pk4_fp8(a.x * ga.x * XS, a.y * ga.y * XS, a.z * ga.z * XS, a.w * ga.w * XS); o.y = pk4_fp8(b.x * gb.x * XS, b.y * gb.y * XS, b.z * gb.z * XS, b.w * gb.w * XS); \
                *(v2u*)(hp + 32 * m) = o; \
                v4u o1; o1.x = cvt_pk_bf16(a.x, a.y); o1.y = cvt_pk_bf16(a.z, a.w); o1.z = cvt_pk_bf16(b.x, b.y); o1.w = cvt_pk_bf16(b.z, b.w); *(v4u*)(x1p + 32 * m) = o1; } } while (0)
            P5_LOAD(0, 0);
#pragma unroll
            for (int bt = 0; bt < 8; bt += 2) {
                P5_LOAD(1, bt + 1);
                P5_COMP(0, bt);
                if (bt + 2 < 8) P5_LOAD(0, bt + 2);
                P5_COMP(1, bt + 1);
            }
#undef P5_LOAD
#undef P5_COMP
            LAS float* cb = comb + (gi * 64 + lane) * 5;
            if (kh == 1) { cb[0] = acc[0]; cb[1] = acc[1]; cb[2] = acc[2]; cb[3] = acc[3]; cb[4] = ss; }
            __syncthreads();
            if (kh == 0) {
                acc[0] += cb[0]; acc[1] += cb[1]; acc[2] += cb[2]; acc[3] += cb[3]; ss += cb[4];
                ss += __shfl_xor(ss, 16); ss += __shfl_xor(ss, 32);
                const float rstd = 1.0f / sqrtf(ss * (1.f / DM) + EPS);
                float l0 = acc[0] * rstd, l1 = acc[1] * rstd, l2 = acc[2] * rstd, l3 = acc[3] * rstd;
                float mx = fmaxf(fmaxf(l0, l1), fmaxf(l2, l3)); mx = fmaxf(mx, __shfl_xor(mx, 16)); mx = fmaxf(mx, __shfl_xor(mx, 32));
                l0 = __expf(l0 - mx); l1 = __expf(l1 - mx); l2 = __expf(l2 - mx); l3 = __expf(l3 - mx);
                float den = (l0 + l1) + (l2 + l3); den += __shfl_xor(den, 16); den += __shfl_xor(den, 32);
                const float rden = 1.0f / den;
                float* ap = AFF + ((size_t)(t0 >> 12) * NE + 4 * kq) * SEQ + (t0 & (SEQ - 1)) + j;
                ap[0] = l0 * rden; ap[SEQ] = l1 * rden; ap[2 * SEQ] = l2 * rden; ap[3 * SEQ] = l3 * rden;
                if (kq == 0) RSTD[t0 + j] = rstd;
            }
            __syncthreads();
        }
        if (BOTH(5)) GRID_BAR();
    }

    if (IN(6)) REP(6) {
        PH_IDS
        LAS unsigned* red = (LAS unsigned*)L;
        for (int be = vcu; be < BATCH * NE; be += G) {
            const int b = be / NE, e = be % NE;
            const float* a = AFF + (size_t)be * SEQ + tid * 8;
            const f32x4 a0 = *(const f32x4*)a, a1 = *(const f32x4*)(a + 4);
            float av[8] = {a0.x, a0.y, a0.z, a0.w, a1.x, a1.y, a1.z, a1.w};
            unsigned key[8];
#pragma unroll
            for (int i = 0; i < 8; ++i) key[i] = __float_as_uint(av[i]);
            unsigned prefix = 0u;
            for (int bit = 30; bit >= 0; --bit) {
                const unsigned cand = prefix | (1u << bit);
                unsigned c = 0u;
#pragma unroll
                for (int i = 0; i < 8; ++i) c += (unsigned)__builtin_popcountll(__ballot(key[i] >= cand));
                LAS unsigned* slot = red + (bit & 1) * 8;
                if (lane == 0) slot[wave] = c;
                __syncthreads();
                unsigned tot = 0u;
#pragma unroll
                for (int w = 0; w < 8; ++w) tot += slot[w];
                if (tot >= (unsigned)CAP) prefix = cand;
            }
            __syncthreads();
            unsigned cgt = 0u, ceq = 0u;
#pragma unroll
            for (int i = 0; i < 8; ++i) { cgt += (key[i] > prefix) ? 1u : 0u; ceq += (key[i] == prefix) ? 1u : 0u; }
            unsigned pk = cgt | (ceq << 16), incl = pk;
#pragma unroll
            for (int o = 1; o < 64; o <<= 1) { const unsigned n = __shfl_up(incl, o); if (lane >= o) incl += n; }
            LAS unsigned* wtot = red + 64;
            if (lane == 63) wtot[wave] = incl;
            __syncthreads();
            unsigned woff = 0u, total = 0u;
#pragma unroll
            for (int w = 0; w < 8; ++w) { const unsigned v = wtot[w]; if (w < wave) woff += v; total += v; }
            const unsigned excl = woff + incl - pk;
            const unsigned need_eq = (unsigned)CAP - (total & 0xffffu);
            unsigned gt_before = excl & 0xffffu, eq_before = excl >> 16;
            const int mbase = (e * BATCH + b) * CAP;
#pragma unroll
            for (int i = 0; i < 8; ++i) {
                const int tok = tid * 8 + i;
                const bool isgt = key[i] > prefix, iseq = key[i] == prefix;
                const bool sel = isgt || (iseq && eq_before < need_eq);
                const unsigned slot = gt_before + (eq_before < need_eq ? eq_before : need_eq);
                if (sel) { IDX[mbase + slot] = tok; GATE[mbase + slot] = av[i]; RS[mbase + slot] = RSTD[(size_t)b * SEQ + tok]; }
                SLOT[((size_t)b * SEQ + tok) * NE + e] = sel ? (int)slot : -1;
                gt_before += isgt ? 1u : 0u; eq_before += iseq ? 1u : 0u;
            }
            __syncthreads();
        }
        if (BOTH(6)) GRID_BAR();
    }


    if (IN(8)) REP(8) {
        pg8::Gemm g{(const bf16*)H8, (const bf16*)WG_T, DM / 2, MS / 256, DFF / 128, (size_t)(WS_WU - WS_WG), (size_t)128 * DM, (size_t)DFF * DM, IDX, (LAS int*)(L + RING_BYTES + 20480)};
        pg8::StaticOrder S; S.WGM = WGM_P8; S.init(MS / 256, DFF / 128, G, bx);
        pg8::EpiSwiGlu8 E{ACT, DFF, 1.0f / (XS * WS), AS, RS};
        const int nmine = (MS / 256 * (DFF / 128) - bx + G - 1) / G, split = nmine > 0 ? vcu % nmine : 0;
        for (int part = 0; part < 2; ++part) {
            S.i0 = part ? split : 0; S.ni = part ? (1 << 30) : split;
            pg8::gemm_phase<pg8::EpiSwiGlu8, pg8::StaticOrder, true, true, true, true>(L, g, S, E);
            if (part == 0) ffn_conv(args.in[9], args.in[10], args.in[11], WG_T, WU_T, WD_T, L, NGU_ITEMS, NFFN_ITEMS - NGU_ITEMS, vcu, G);
        }
        if (BOTH(8)) GRID_BAR();
    }

    if (IN(9)) REP(9) {
        pg8::Gemm g{(const bf16*)ACT, (const bf16*)WD_T, DFF / 2, MS / 256, DM / 256, (size_t)128 * DFF, (size_t)256 * DFF, (size_t)DM * DFF, nullptr, nullptr};
        pg8::StaticOrder S; S.WGM = WGM_P9; S.init(MS / 256, DM / 256, G, bx);
        pg8::EpiBf16 E{EO, DM, 1.0f / (AS * WDS)};
        pg8::gemm_phase<pg8::EpiBf16, pg8::StaticOrder, true, true, true>(L, g, S, E);
        if (BOTH(9)) GRID_BAR();
    }

    if (IN(10)) REP(10) {
        PH_IDS
        const unsigned bad = __hip_atomic_load(ctl + CW_BAR + XB_TMO, RLX_AGENT);
        f32x4 gg[8];
#pragma unroll
        for (int j = 0; j < 8; ++j) gg[j] = ((const f32x4*)args.in[12])[lane + 64 * j];
        for (int t = gw; t < T; t += NGW) {
            const v2u* mr = (const v2u*)(X1 + (size_t)t * DM) + lane;
            f32x4 v[8];
#pragma unroll
            for (int j = 0; j < 8; ++j) { const v2u w = __builtin_nontemporal_load(mr + 64 * j); v[j].x = bf_lo(w.x); v[j].y = bf_hi(w.x); v[j].z = bf_lo(w.y); v[j].w = bf_hi(w.y); }
            const int myslot = SLOT[(size_t)t * NE + (lane & 15)];
            const int b = t >> 12;
            for (int e = 0; e < NE; ++e) {
                const int sl = __builtin_amdgcn_readlane(myslot, e);
                if (sl >= 0) {
                    const int m = (e * BATCH + b) * CAP + sl; const float gt = GATE[m];
                    const v2u* er = (const v2u*)(EO + (size_t)m * DM) + lane;
#pragma unroll
                    for (int j = 0; j < 8; ++j) { const v2u w = __builtin_nontemporal_load(er + 64 * j); v[j].x += gt * bf_lo(w.x); v[j].y += gt * bf_hi(w.x); v[j].z += gt * bf_lo(w.y); v[j].w += gt * bf_hi(w.y); }
                }
            }
            float s = 0.f;
#pragma unroll
            for (int j = 0; j < 8; ++j) s += (v[j].x * v[j].x + v[j].y * v[j].y) + (v[j].z * v[j].z + v[j].w * v[j].w);
            const float rstd = bad ? __builtin_nanf("") : 1.0f / sqrtf(wave_sum(s) * (1.f / DM) + EPS);
            f32x4* orow = (f32x4*)(args.out + (size_t)t * DM) + lane;
#pragma unroll
            for (int j = 0; j < 8; ++j) __builtin_nontemporal_store(v[j] * rstd * gg[j], orow + 64 * j);
        }
    }
#undef PH_IDS
#undef IN
#undef BOTH
#undef GRID_BAR
}

extern "C" void kernel_launch(void* const* d_in, const int* in_sizes, int n_in, void* d_out, int out_size, void* d_ws, size_t ws_size, hipStream_t stream) {
    static int grid = 0;
    if (grid == 0) {
        if (n_in != 13 || in_sizes[0] != T * DM || out_size != T * DM || ws_size < WS_END) {
            fprintf(stderr, "kernel_launch: shape mismatch: n_in %d in0 %d out %d ws %zu (need >= %zu)\n", n_in, n_in > 0 ? in_sizes[0] : -1, out_size, ws_size, (size_t)WS_END); grid = -1; return; }
        int dev = 0, cus = 0;
        if (hipGetDevice(&dev) != hipSuccess || hipDeviceGetAttribute(&cus, hipDeviceAttributeMultiprocessorCount, dev) != hipSuccess) { grid = -1; return; }
        if (hipFuncSetAttribute((const void*)hymba_fwd, hipFuncAttributeMaxDynamicSharedMemorySize, LDS_BYTES) != hipSuccess) { fprintf(stderr, "kernel_launch: hipFuncSetAttribute failed\n"); grid = -1; return; }
        int per_cu = 0;
        if (hipOccupancyMaxActiveBlocksPerMultiprocessor(&per_cu, (const void*)hymba_fwd, NWAVES * 64, LDS_BYTES) != hipSuccess || per_cu < 1)
            fprintf(stderr, "kernel_launch: note: occupancy query reports %d workgroups per CU\n", per_cu);
        (void)hipGetLastError();
        grid = cus;
    }
    if (grid < 0) return;
    if (hipMemsetAsync((char*)d_ws + WS_CTL, 0, CTL_ZERO_BYTES, stream) != hipSuccess) { fprintf(stderr, "kernel_launch: memset failed\n"); return; }
    Args a{};
    for (int i = 0; i < 13; ++i) a.in[i] = (const float*)d_in[i];
    a.out = (float*)d_out; a.ws = (unsigned char*)d_ws;
#if MK_SPLIT
    for (int p = 0; p < NPHASE; ++p) { a.ph_lo = p; a.ph_hi = p + 1; hipLaunchKernelGGL(hymba_fwd, dim3(grid), dim3(NWAVES * 64), LDS_BYTES, stream, a); }
#else
    a.ph_lo = 0; a.ph_hi = NPHASE;
    hipLaunchKernelGGL(hymba_fwd, dim3(grid), dim3(NWAVES * 64), LDS_BYTES, stream, a);
#endif
    const hipError_t le = hipPeekAtLastError();
    if (le != hipSuccess) fprintf(stderr, "kernel_launch: launch failed: %s\n", hipGetErrorName(le));
}
```
